# Optimizing an MI355X kernel written in HIP

```python
import jax
import jax.numpy as jnp
from jax import lax
import numpy as np

D_MODEL = 1024
BATCH = 8
SEQ = 2048
DEPTH = 2

GRID_W = 64
CTX_LEN = 256
HEAD_DIM = 64
NA_HEADS = D_MODEL // (2 * HEAD_DIM)
GQA_HEADS = D_MODEL // (2 * HEAD_DIM)
GQA_KV_HEADS = GQA_HEADS // 4
GQA_GROUP = GQA_HEADS // GQA_KV_HEADS
NA_WIDTH = NA_HEADS * HEAD_DIM
GQA_WIDTH = GQA_HEADS * HEAD_DIM
GQA_KV_WIDTH = GQA_KV_HEADS * HEAD_DIM
MIX_WIDTH = NA_WIDTH + GQA_WIDTH
IN_WIDTH = 3 * NA_WIDTH + GQA_WIDTH + 2 * GQA_KV_WIDTH
IN_SPLITS = (NA_WIDTH, 2 * NA_WIDTH, 3 * NA_WIDTH, 3 * NA_WIDTH + GQA_WIDTH,
             3 * NA_WIDTH + GQA_WIDTH + GQA_KV_WIDTH)
NA_WIN_H = 8
NA_WIN_W = 16
RPB_H = 2 * NA_WIN_H - 1
RPB_W = 2 * NA_WIN_W - 1
D_FF = 2816
N_MOD = 9
Q_BLOCK = 128
ROPE_THETA = 10000.0
EPS = 1e-6
NEG_INF = -1e30

kernel_name = 'hybrid_na_gqa_macaron_dit'


def rms_norm(x, g):
    xf = x.astype(jnp.float32)
    y = xf * lax.rsqrt(jnp.mean(xf * xf, axis=-1, keepdims=True) + EPS)
    return (y * g.astype(jnp.float32)).astype(x.dtype)


def modulate(h, shift, scale):
    return h * (1 + scale) + shift


def ada_mod(cond, w_mod, b_mod):
    m = (jax.nn.silu(cond) @ w_mod + b_mod)[..., None, :]
    return jnp.split(m, N_MOD, axis=-1)


def swiglu(h, w13, w2):
    a, g = jnp.split(h @ w13, 2, axis=-1)
    return (jax.nn.silu(g) * a) @ w2


def ffn_half(x, norm_g, shift, scale, gate, w13, w2):
    h = modulate(rms_norm(x, norm_g), shift, scale)
    return x + 0.5 * gate * swiglu(h, w13, w2)


def axial_rope_tables(seq_len, dtype):
    t = jnp.arange(seq_len, dtype=jnp.int32)
    row = (t // GRID_W).astype(jnp.float32)
    col = (t % GRID_W).astype(jnp.float32)
    axis_dim = HEAD_DIM // 2
    inv_freq = ROPE_THETA ** (-jnp.arange(0, axis_dim, 2, dtype=jnp.float32) / axis_dim)
    ang_r = row[:, None] * inv_freq[None, :]
    ang_c = col[:, None] * inv_freq[None, :]
    return (jnp.cos(ang_r).astype(dtype), jnp.sin(ang_r).astype(dtype),
            jnp.cos(ang_c).astype(dtype), jnp.sin(ang_c).astype(dtype))


def rope_1d(x, cos, sin):
    x1, x2 = jnp.split(x, 2, axis=-1)
    return jnp.concatenate([x1 * cos - x2 * sin, x2 * cos + x1 * sin], axis=-1)


def apply_axial_rope(x, rope):
    cos_r, sin_r, cos_c, sin_c = rope
    xr, xc = jnp.split(x, 2, axis=-1)
    return jnp.concatenate([rope_1d(xr, cos_r, sin_r), rope_1d(xc, cos_c, sin_c)], axis=-1)


def split_heads(t, n_heads):
    b, l, _ = t.shape
    return t.reshape(b, l, n_heads, HEAD_DIM).transpose(0, 2, 1, 3)


def merge_heads(t):
    b, h, l, d = t.shape
    return t.transpose(0, 2, 1, 3).reshape(b, l, h * d)


def combined_projection(h, w_in):
    qa, ka, va, qb, kb, vb = jnp.split(h @ w_in, IN_SPLITS, axis=-1)
    return (split_heads(qa, NA_HEADS), split_heads(ka, NA_HEADS), split_heads(va, NA_HEADS),
            split_heads(qb, GQA_HEADS), split_heads(kb, GQA_KV_HEADS), split_heads(vb, GQA_KV_HEADS))


def neighbourhood_attention(q, k, v, k_ctx, v_ctx, rpb):
    b, h, l, d = q.shape
    rows = l // GRID_W
    kh = min(NA_WIN_H, rows)
    scale = d ** -0.5
    qg = q.reshape(b, h, rows, GRID_W, d)
    kg = k.reshape(b, h, rows, GRID_W, d)
    vg = v.reshape(b, h, rows, GRID_W, d)
    r = jnp.arange(rows)
    row_start = jnp.clip(r - kh // 2, 0, rows - kh)
    key_rows = row_start[:, None] + jnp.arange(kh)[None, :]
    k_blk = kg[:, :, key_rows]
    v_blk = vg[:, :, key_rows]
    cq = jnp.arange(GRID_W)
    col_start = jnp.clip(cq - NA_WIN_W // 2, 0, GRID_W - NA_WIN_W)
    in_win = (cq[None, :] >= col_start[:, None]) & (cq[None, :] < col_start[:, None] + NA_WIN_W)
    row_off = key_rows - r[:, None]
    col_off = jnp.clip(cq[None, :] - cq[:, None] + NA_WIN_W - 1, 0, RPB_W - 1)
    bias = rpb[:, (row_off + NA_WIN_H - 1)[:, None, :, None], col_off[None, :, None, :]]
    s_loc = jnp.einsum('bhrqd,bhrnkd->bhrqnk', qg, k_blk).astype(jnp.float32) * scale
    s_loc = s_loc + bias[None].astype(jnp.float32)
    s_loc = jnp.where(in_win[:, None, :], s_loc, NEG_INF)
    s_loc = s_loc.reshape(b, h, rows, GRID_W, kh * GRID_W)
    s_ctx = jnp.einsum('bhrqd,bhcd->bhrqc', qg, k_ctx).astype(jnp.float32) * scale
    p = jax.nn.softmax(jnp.concatenate([s_loc, s_ctx], axis=-1), axis=-1).astype(v.dtype)
    p_loc = p[..., :kh * GRID_W].reshape(b, h, rows, GRID_W, kh, GRID_W)
    p_ctx = p[..., kh * GRID_W:]
    o = (jnp.einsum('bhrqnk,bhrnkd->bhrqd', p_loc, v_blk)
         + jnp.einsum('bhrqc,bhcd->bhrqd', p_ctx, v_ctx))
    return o.reshape(b, h, l, d)


def gqa_blocked_attention(q, k_all, v_all):
    b, kvh, g, l, d = q.shape
    scale = d ** -0.5
    nb = l // Q_BLOCK
    qb = q.reshape(b, kvh, g, nb, Q_BLOCK, d).transpose(3, 0, 1, 2, 4, 5)

    def one_block(q_blk):
        s = jnp.einsum('bkgqd,bknd->bkgqn', q_blk, k_all).astype(jnp.float32) * scale
        p = jax.nn.softmax(s, axis=-1).astype(v_all.dtype)
        return jnp.einsum('bkgqn,bknd->bkgqd', p, v_all)

    o = lax.map(one_block, qb)
    return o.transpose(1, 2, 3, 0, 4, 5).reshape(b, kvh, g, l, d)


def dense_group_attention(q, k, v):
    s = jnp.einsum('bkgqd,bkcd->bkgqc', q, k).astype(jnp.float32) * (q.shape[-1] ** -0.5)
    p = jax.nn.softmax(s, axis=-1).astype(v.dtype)
    return jnp.einsum('bkgqc,bkcd->bkgqd', p, v)


def merge_groups(o_a, o_b, g_a, g_b, w_out):
    y = jnp.concatenate([rms_norm(merge_heads(o_a), g_a), rms_norm(merge_heads(o_b), g_b)], axis=-1)
    return y @ w_out


def mixer_sublayer(x, x_ctx, mod, mod_ctx, norm_g, w_in, rpb, q_norm, k_norm, g_a, g_b, w_out, rope, update_ctx):
    shift, scale, gate = mod
    shift_c, scale_c, gate_c = mod_ctx
    h = modulate(rms_norm(x, norm_g), shift, scale)
    h_c = modulate(rms_norm(x_ctx, norm_g), shift_c, scale_c)
    qa, ka, va, qb, kb, vb = combined_projection(h, w_in)
    qa_c, ka_c, va_c, qb_c, kb_c, vb_c = combined_projection(h_c, w_in)
    kb_c = rms_norm(kb_c, k_norm)
    o_a = neighbourhood_attention(qa, ka, va, ka_c, va_c, rpb)
    qb = apply_axial_rope(rms_norm(qb, q_norm), rope)
    kb = apply_axial_rope(rms_norm(kb, k_norm), rope)
    b, _, l, _ = qb.shape
    k_all = jnp.concatenate([kb, kb_c], axis=2)
    v_all = jnp.concatenate([vb, vb_c], axis=2)
    o_b = gqa_blocked_attention(qb.reshape(b, GQA_KV_HEADS, GQA_GROUP, l, HEAD_DIM), k_all, v_all)
    o_b = o_b.reshape(b, GQA_HEADS, l, HEAD_DIM)
    x = x + gate * merge_groups(o_a, o_b, g_a, g_b, w_out)
    if update_ctx:
        cl = x_ctx.shape[1]
        o_a_c = dense_group_attention(qa_c[:, :, None], ka_c, va_c)[:, :, 0]
        o_b_c = dense_group_attention(
            rms_norm(qb_c, q_norm).reshape(b, GQA_KV_HEADS, GQA_GROUP, cl, HEAD_DIM), kb_c, vb_c)
        o_b_c = o_b_c.reshape(b, GQA_HEADS, cl, HEAD_DIM)
        x_ctx = x_ctx + gate_c * merge_groups(o_a_c, o_b_c, g_a, g_b, w_out)
    return x, x_ctx


def setup_inputs(seed: int = 0) -> dict:
    key = jax.random.key(seed)
    ks = jax.random.split(key, 24)
    f32 = jnp.float32

    def nrm(k, shape, s):
        return jax.random.normal(k, shape, f32) * s

    def gain(k, shape):
        return 1.0 + 0.05 * jax.random.normal(k, shape, f32)

    return {
        'x': nrm(ks[0], (BATCH, SEQ, D_MODEL), 1.0),
        'c': nrm(ks[1], (BATCH, D_MODEL), 1.0),
        'ctx': nrm(ks[2], (BATCH, CTX_LEN, D_MODEL), 1.0),
        'c_ctx': nrm(ks[3], (D_MODEL,), 1.0),
        'w_mod': nrm(ks[4], (DEPTH, D_MODEL, N_MOD * D_MODEL), 0.5 * D_MODEL ** -0.5),
        'b_mod': nrm(ks[5], (DEPTH, N_MOD * D_MODEL), 0.01),
        'norm_ffn1': gain(ks[6], (DEPTH, D_MODEL)),
        'ffn1_w13': nrm(ks[7], (DEPTH, D_MODEL, 2 * D_FF), D_MODEL ** -0.5),
        'ffn1_w2': nrm(ks[8], (DEPTH, D_FF, D_MODEL), D_FF ** -0.5),
        'norm_mix': gain(ks[9], (DEPTH, D_MODEL)),
        'w_in': nrm(ks[10], (DEPTH, D_MODEL, IN_WIDTH), D_MODEL ** -0.5),
        'na_rpb': nrm(ks[11], (DEPTH, NA_HEADS, RPB_H, RPB_W), 0.1),
        'gqa_q_norm': gain(ks[12], (DEPTH, HEAD_DIM)),
        'gqa_k_norm': gain(ks[13], (DEPTH, HEAD_DIM)),
        'out_norm_a': gain(ks[14], (DEPTH, NA_WIDTH)),
        'out_norm_b': gain(ks[15], (DEPTH, GQA_WIDTH)),
        'w_out': nrm(ks[16], (DEPTH, MIX_WIDTH, D_MODEL), MIX_WIDTH ** -0.5),
        'norm_ffn2': gain(ks[17], (DEPTH, D_MODEL)),
        'ffn2_w13': nrm(ks[18], (DEPTH, D_MODEL, 2 * D_FF), D_MODEL ** -0.5),
        'ffn2_w2': nrm(ks[19], (DEPTH, D_FF, D_MODEL), D_FF ** -0.5),
        'norm_f': gain(ks[20], (D_MODEL,)),
    }


def reference(x, c, ctx, c_ctx, w_mod, b_mod, norm_ffn1, ffn1_w13, ffn1_w2, norm_mix, w_in, na_rpb,
              gqa_q_norm, gqa_k_norm, out_norm_a, out_norm_b, w_out, norm_ffn2, ffn2_w13, ffn2_w2, norm_f):
    rope = axial_rope_tables(x.shape[1], x.dtype)
    x_ctx = ctx
    for i in range(DEPTH):
        last = i == DEPTH - 1
        m = ada_mod(c, w_mod[i], b_mod[i])
        mc = ada_mod(c_ctx, w_mod[i], b_mod[i])
        x = ffn_half(x, norm_ffn1[i], m[0], m[1], m[2], ffn1_w13[i], ffn1_w2[i])
        x_ctx = ffn_half(x_ctx, norm_ffn1[i], mc[0], mc[1], mc[2], ffn1_w13[i], ffn1_w2[i])
        x, x_ctx = mixer_sublayer(x, x_ctx, m[3:6], mc[3:6], norm_mix[i], w_in[i], na_rpb[i],
                                  gqa_q_norm[i], gqa_k_norm[i], out_norm_a[i], out_norm_b[i], w_out[i],
                                  rope, not last)
        x = ffn_half(x, norm_ffn2[i], m[6], m[7], m[8], ffn2_w13[i], ffn2_w2[i])
        if not last:
            x_ctx = ffn_half(x_ctx, norm_ffn2[i], mc[6], mc[7], mc[8], ffn2_w13[i], ffn2_w2[i])
    return rms_norm(x, norm_f)
```

```cpp
#include <hip/hip_runtime.h>
#include <hip/hip_bf16.h>
#include <hip/hip_cooperative_groups.h>
#include <cstdio>
#include <cstdint>
#include <cmath>
namespace cg = cooperative_groups;
#define WS_O_BYTES 265289728ull
#define WS_END_BYTES 303038464ull
#define WS_U_BYTES 161480704ull
namespace pg8 {
#define PG8_LAS __attribute__((address_space(3)))
typedef unsigned short bf16_t;
typedef short bf16x8 __attribute__((ext_vector_type(8)));
typedef float f32x4 __attribute__((ext_vector_type(4)));
typedef unsigned u32x4 __attribute__((ext_vector_type(4)));
constexpr int BM = 256, BK = 64, HALF = 128, HTB = HALF * BK * 2  , STAGE_BYTES = 8 * HTB, NXCD = 8, WGM = 8;

__host__ __device__ __forceinline__ int lds_byte(int r, int c) { const int st = (r >> 4) * 2 + (c >> 5), rr = r & 15, cc = c & 31, ob = rr * 64 + cc * 2; return st * 1024 + (ob ^ (((ob >> 9) & 1) << 5)); }
__host__ __device__ __forceinline__ void stage_rc(int b, int& R, int& C) { const int st = b / 1024, sb = b % 1024, swz = sb ^ (((sb >> 9) & 1) << 5); R = (st >> 1) * 16 + swz / 64; C = (st & 1) * 32 + (swz % 64) / 2; }
__host__ __device__ __forceinline__ int perm32(int rho) { const int n = rho >> 4, i = rho & 15; return 8 * (i >> 2) + 4 * n + (i & 3); }

struct Unit { int pm, pn, k0, nk, ch, part; };
struct Gemm { const bf16_t* A; const bf16_t* Bt; int M, N, K; };

struct StaticOrder {
    int nM, nN, nwg, G, c;
    __host__ __device__ void init(int M, int N, int G_, int c_) { nM = M / BM; nN = N / BM; nwg = nM * nN; G = G_; c = c_; }
    __host__ __device__ bool next(int i, Unit& u) const {
        const long L = (long)i * G + c; if (L >= nwg) return false;
        int wgid = (int)L; { const int q = nwg / NXCD, r = nwg % NXCD, xcd = wgid % NXCD, off = wgid / NXCD; wgid = (xcd < r ? xcd * (q + 1) : r * (q + 1) + (xcd - r) * q) + off; }
        const int nig = WGM * nN, gid = wgid / nig, fm = gid * WGM, gsz = (nM - fm) < WGM ? (nM - fm) : WGM;
        u.pm = fm + ((wgid % nig) % gsz); u.pn = (wgid % nig) / gsz; u.k0 = 0; u.nk = 0; u.ch = 0; u.part = 0; return true;
    }
    __device__ __forceinline__ void a_ready(const Unit&) const {}
    __device__ __forceinline__ void done(const Unit&) const {}
};

__device__ __forceinline__ unsigned cvt_pk_bf16(float lo, float hi) { unsigned r; asm volatile("v_cvt_pk_bf16_f32 %0, %1, %2" : "=v"(r) : "v"(lo), "v"(hi)); return r; }
typedef float f32x2 __attribute__((ext_vector_type(2)));
typedef unsigned u32x2 __attribute__((ext_vector_type(2)));
constexpr size_t SLAB_BYTES = (size_t)2048 * 1024 * 4, SLAB_WS_O = (size_t)WS_O_BYTES, SLAB_WS_END = (size_t)WS_END_BYTES, SLAB_OUT = (size_t)36 << 20;
__device__ __forceinline__ float* part_slab(unsigned char* ws, unsigned char* outb, int ch, int sel) {
    if (sel) return (float*)(ws + WS_U_BYTES + (size_t)ch * SLAB_BYTES);
    return (float*)(ch < 4 ? ws + SLAB_WS_O + (size_t)ch * SLAB_BYTES : (ch == 4 ? ws + SLAB_WS_END : outb + SLAB_OUT + (size_t)(ch - 5) * SLAB_BYTES));
}
struct EpiSwiglu {
    static constexpr bool PERM = true, AFTER_DRAIN = false;
    bf16_t* U; int ldu;
    __device__ __forceinline__ void operator()(const f32x4 (&acc)[2][2][4][2], const Unit& u, int wr, int wc, int fr, int fq) const {
        const int row0 = u.pm * BM + wr * 64 + fr, col0 = u.pn * HALF + wc * 32 + 8 * fq;
#pragma unroll
        for (int ai = 0; ai < 2; ++ai)
#pragma unroll
            for (int m = 0; m < 4; ++m) {
                float r[8];
#pragma unroll
                for (int n = 0; n < 2; ++n)
#pragma unroll
                    for (int e = 0; e < 4; ++e) { const float a = acc[ai][0][m][n][e], g = acc[ai][1][m][n][e];
                        r[n * 4 + e] = a * g * __builtin_amdgcn_rcpf(1.0f + __builtin_amdgcn_exp2f(-1.4426950408889634f * g)); }
                u32x4 w; w.x = cvt_pk_bf16(r[0], r[1]); w.y = cvt_pk_bf16(r[2], r[3]); w.z = cvt_pk_bf16(r[4], r[5]); w.w = cvt_pk_bf16(r[6], r[7]);
                *(u32x4*)(U + (size_t)(row0 + ai * HALF + m * 16) * ldu + col0) = w; }
    }
};
struct EpiResid {
    static constexpr bool PERM = false, AFTER_DRAIN = false;
    float* X; const float* gate; float s;
    unsigned char* ws; unsigned char* outb; int sel;
    __device__ __forceinline__ void operator()(const f32x4 (&acc)[2][2][4][2], const Unit& u, int wr, int wc, int fr, int fq) const {
        const int j = (u.pm % 9 == 8) ? 8 : u.pm / 9;
        const int row0 = u.pm * BM + wr * 64 + fr, col0 = u.pn * BM + wc * 32 + 4 * fq;
        const float* gp = gate + (size_t)j * 9216 + col0;
        float* slab = u.part ? part_slab(ws, outb, u.ch, sel) - (size_t)16384 * 1024 : X;
        f32x4 gv[2][2];
#pragma unroll
        for (int bj = 0; bj < 2; ++bj)
#pragma unroll
            for (int n = 0; n < 2; ++n) gv[bj][n] = *(const f32x4*)(gp + bj * HALF + n * 16) * s;
#pragma unroll
        for (int ai = 0; ai < 2; ++ai)
#pragma unroll
            for (int m = 0; m < 4; ++m) { float* rowp = X + (size_t)(row0 + ai * HALF + m * 16) * 1024 + col0;
#pragma unroll
                for (int bj = 0; bj < 2; ++bj)
#pragma unroll
                    for (int n = 0; n < 2; ++n) { float* pf = rowp + bj * HALF + n * 16; const f32x4 d = gv[bj][n] * acc[ai][bj][m][n];
                        if (u.part) *(f32x4*)(slab + (pf - X)) = d;
                        else { f32x4* p = (f32x4*)pf; *p = *p + d; } }
                if (m & 1) asm volatile("" ::: "memory"); }
    }
};
struct EpiQkv {
    static constexpr bool PERM = true, AFTER_DRAIN = false;
    bf16_t* QKV; const float* qn; const float* kn; const float* rc; const float* rs; float c2; float eps;
    __device__ __forceinline__ void operator()(const f32x4 (&acc)[2][2][4][2], const Unit& u, int wr, int wc, int fr, int fq) const {
        const int hh = u.pn * 4 + wc;
        const bool isq = (hh < 8) || (hh >= 24 && hh < 32), nrm = (hh >= 24 && hh < 34);
        const float* gn = (hh < 32) ? qn : kn;
        const int tq = u.pm % 9; const bool latent = tq != 8; const int tbase = tq * 256;
        f32x4 gv[2][2];
#pragma unroll
        for (int bj = 0; bj < 2; ++bj)
#pragma unroll
            for (int n = 0; n < 2; ++n) gv[bj][n] = nrm ? *(const f32x4*)(gn + 32 * bj + 16 * n + 4 * fq) : (f32x4){1.f, 1.f, 1.f, 1.f};
        const float osc = isq ? c2 : 1.0f;
#pragma unroll
        for (int ai = 0; ai < 2; ++ai)
#pragma unroll
            for (int m = 0; m < 4; ++m) {
                const int rit = ai * HALF + wr * 64 + m * 16 + fr; const size_t row = (size_t)u.pm * BM + rit;
                f32x4 v[2][2];
#pragma unroll
                for (int bj = 0; bj < 2; ++bj)
#pragma unroll
                    for (int n = 0; n < 2; ++n) v[bj][n] = acc[ai][bj][m][n];
                if (nrm) {
                    float ss = 0.f;
#pragma unroll
                    for (int bj = 0; bj < 2; ++bj)
#pragma unroll
                        for (int n = 0; n < 2; ++n) ss += (v[bj][n][0] * v[bj][n][0] + v[bj][n][1] * v[bj][n][1]) + (v[bj][n][2] * v[bj][n][2] + v[bj][n][3] * v[bj][n][3]);
                    ss += __shfl_xor(ss, 16); ss += __shfl_xor(ss, 32);
                    const float r = 1.0f / sqrtf(ss * (1.0f / 64.0f) + eps);
#pragma unroll
                    for (int bj = 0; bj < 2; ++bj)
#pragma unroll
                        for (int n = 0; n < 2; ++n) v[bj][n] = v[bj][n] * r * gv[bj][n];
                    if (latent) {
                        const int t = tbase + rit, pr = t >> 6, pc = t & 63;
#pragma unroll
                        for (int bj = 0; bj < 2; ++bj) { const int pos = bj ? pc : pr;
                            const f32x4 co = *(const f32x4*)(rc + pos * 16 + 4 * fq), si = *(const f32x4*)(rs + pos * 16 + 4 * fq);
                            const f32x4 x1 = v[bj][0], x2 = v[bj][1];
                            v[bj][0] = x1 * co - x2 * si; v[bj][1] = x2 * co + x1 * si; }
                    }
                }
                bf16_t* op = QKV + row * 2304 + hh * 64 + 4 * fq;
#pragma unroll
                for (int bj = 0; bj < 2; ++bj)
#pragma unroll
                    for (int n = 0; n < 2; ++n) { const f32x4 o = v[bj][n] * osc; u32x2 w; w.x = cvt_pk_bf16(o[0], o[1]); w.y = cvt_pk_bf16(o[2], o[3]); *(u32x2*)(op + 32 * bj + 16 * n) = w; }
                asm volatile("" ::: "memory");
            }
    }
};
struct Sched2 {
    int nM, nN, nwg, G, c, nt, full, cpu; bool skip;
    __device__ __forceinline__ void init(int N, int K, int G_, int c_, bool latent_only, bool split) {
        nM = latent_only ? 64 : 72; nN = N / BM; nwg = nM * nN; G = G_; c = c_; nt = K / BK; skip = latent_only; full = nwg; cpu = 0;
        if (split) { const int rem = nwg % G; if (rem == 32 && nwg == 288 && G == 256 && (nt / 2) >= G / rem)   { full = nwg - rem; cpu = G / rem; } }
    }
    __device__ __forceinline__ bool next(int i, Unit& u) const {
        const int L = i * G + c;
        int wgid, k0 = 0, nk = nt, ch = 0, part = 0;
        if (L < full) { wgid = L; const int q = full / NXCD, r = full % NXCD, xcd = wgid % NXCD, off = wgid / NXCD; wgid = (xcd < r ? xcd * (q + 1) : r * (q + 1) + (xcd - r) * q) + off; }
        else if (cpu && L < full + G) { const int j = L - full; ch = j % cpu; wgid = full + j / cpu;
            const int pairs = nt / 2, base = pairs / cpu, ext = pairs % cpu; k0 = 2 * (ch * base + (ch < ext ? ch : ext)); nk = 2 * (base + (ch < ext ? 1 : 0)); part = 1; }
        else return false;
        const int nig = WGM * nN, gid = wgid / nig, fm = gid * WGM, gsz = (nM - fm) < WGM ? (nM - fm) : WGM;
        int pm = fm + ((wgid % nig) % gsz); const int pn = (wgid % nig) / gsz;
        if (skip) pm += pm >> 3;
        u.pm = pm; u.pn = pn; u.k0 = k0; u.nk = nk; u.ch = ch; u.part = part;
        return true;
    }
    __device__ __forceinline__ void a_ready(const Unit&) const {}
    __device__ __forceinline__ void done(const Unit&) const {}
};
template <class Epi, class Sched, bool ALIGN_EPI = false, bool SP2 = false>
__device__ __forceinline__ void gemm_phase(PG8_LAS unsigned char* lds, const Gemm g, const Sched& S, const Epi& E) {
    int tid_ = threadIdx.x; asm volatile("" : "+v"(tid_));
    const int tid = tid_, wid = __builtin_amdgcn_readfirstlane(tid >> 6), lane = tid & 63, wr = wid >> 2, wc = wid & 3, fr = lane & 15, fq = lane >> 4;
    const int K = g.K;
    unsigned voffA[2], voffB[2];
#pragma unroll
    for (int i = 0; i < 2; ++i) { int R, C; stage_rc(tid * 16 + i * 8192, R, C); const int Rb = Epi::PERM ? ((R & ~31) + perm32(R & 31)) : R;
        voffA[i] = (unsigned)(R * K + C) * 2u; voffB[i] = (unsigned)(Rb * K + C) * 2u; }
    const size_t kstep = (size_t)(BK * 2);
    const size_t hstep = (size_t)HALF * K * 2;
    const size_t tstep = 2 * hstep;
    const unsigned ldsw = (unsigned)wid * 1024u;
    const int aoff = lds_byte(wr * 64 + fr, fq * 8), boff = lds_byte(wc * 32 + fr, fq * 8);
#define PG8_SA(b, h) (((b) * 2 + (h)) * HTB)
#define PG8_SB(b, h) ((4 + (b) * 2 + (h)) * HTB)
#define PG8_STAGE(bufoff, gbase, voff) do { _Pragma("unroll") for (int _i = 0; _i < 2; ++_i) \
        __builtin_amdgcn_global_load_lds((const unsigned*)((const char*)(gbase) + (voff)[_i]), (PG8_LAS unsigned*)(lds + (bufoff) + ldsw + _i * 8192), 16, 0, 0); } while (0)
#define PG8_LDA(dst, b, h) do { _Pragma("unroll") for (int m = 0; m < 4; ++m) _Pragma("unroll") for (int k = 0; k < 2; ++k) dst[m][k] = *(const PG8_LAS bf16x8*)(lds + PG8_SA(b, h) + aoff + m * 2048 + k * 1024); } while (0)
#define PG8_LDB(dst, b, h) do { _Pragma("unroll") for (int n = 0; n < 2; ++n) _Pragma("unroll") for (int k = 0; k < 2; ++k) dst[n][k] = *(const PG8_LAS bf16x8*)(lds + PG8_SB(b, h) + boff + n * 2048 + k * 1024); } while (0)
#define PG8_MMA(ai, bj, At, Bt) do { __builtin_amdgcn_s_setprio(1); _Pragma("unroll") for (int m = 0; m < 4; ++m) _Pragma("unroll") for (int n = 0; n < 2; ++n) _Pragma("unroll") for (int k = 0; k < 2; ++k) \
        acc[ai][bj][m][n] = __builtin_amdgcn_mfma_f32_16x16x32_bf16(Bt[n][k], At[m][k], acc[ai][bj][m][n], 0, 0, 0); __builtin_amdgcn_s_setprio(0); } while (0)
#define PG8_WAIT_V(n) asm volatile("s_waitcnt vmcnt(" #n ")" ::: "memory")
#define PG8_WAIT_L(n) asm volatile("s_waitcnt lgkmcnt(" #n ")" ::: "memory")
#define PG8_BAR __builtin_amdgcn_s_barrier()
#define PG8_SCHED __builtin_amdgcn_sched_barrier(0)
    Unit cur, nxt; int ui = 0;
    if (!S.next(0, cur)) return;
    f32x4 acc[2][2][4][2];
#pragma unroll
    for (int a = 0; a < 2; ++a)
#pragma unroll
        for (int b = 0; b < 2; ++b)
#pragma unroll
            for (int m = 0; m < 4; ++m)
#pragma unroll
                for (int n = 0; n < 2; ++n) acc[a][b][m][n] = (f32x4){0.f, 0.f, 0.f, 0.f};
    bf16x8 At[4][2], B0[2][2], B1[2][2];
    const char* cA = (const char*)g.A + (size_t)cur.pm * tstep + (size_t)cur.k0 * kstep; const char* cB = (const char*)g.Bt + (size_t)cur.pn * tstep + (size_t)cur.k0 * kstep;
    S.a_ready(cur);
    if constexpr (SP2) {
        PG8_STAGE(PG8_SB(0, 0), cB, voffB); PG8_STAGE(PG8_SB(0, 1), cB + hstep, voffB); PG8_STAGE(PG8_SA(0, 0), cA, voffA); PG8_STAGE(PG8_SA(0, 1), cA + hstep, voffA);
        if (wr == 1) PG8_BAR;
        PG8_WAIT_V(2); PG8_BAR;
        PG8_STAGE(PG8_SB(1, 0), cB + kstep, voffB); PG8_STAGE(PG8_SA(1, 0), cA + kstep, voffA); PG8_STAGE(PG8_SB(1, 1), cB + hstep + kstep, voffB);
        PG8_WAIT_V(6); PG8_BAR;
    } else {
        PG8_STAGE(PG8_SB(0, 0), cB, voffB); PG8_STAGE(PG8_SA(0, 0), cA, voffA); PG8_STAGE(PG8_SB(0, 1), cB + hstep, voffB); PG8_STAGE(PG8_SA(0, 1), cA + hstep, voffA);
        if (wr == 1) PG8_BAR;
        PG8_WAIT_V(4); PG8_BAR;
        PG8_STAGE(PG8_SB(1, 0), cB + kstep, voffB); PG8_STAGE(PG8_SA(1, 0), cA + kstep, voffA); PG8_STAGE(PG8_SB(1, 1), cB + hstep + kstep, voffB);
        PG8_WAIT_V(6); PG8_BAR;
    }
    for (;;) {
        const bool has_next = S.next(ui + 1, nxt);
        const char* nA = has_next ? (const char*)g.A + (size_t)nxt.pm * tstep + (size_t)nxt.k0 * kstep : cA; const char* nB = has_next ? (const char*)g.Bt + (size_t)nxt.pn * tstep + (size_t)nxt.k0 * kstep : cB;
        const int nt = cur.nk;
        for (int t = 0; t < nt; t += 2) {
            const bool last = (t == nt - 2);
            const char* a1 = cA + (size_t)(t + 1) * kstep;
            const char* a2 = last ? nA : cA + (size_t)(t + 2) * kstep; const char* b2 = last ? nB : cB + (size_t)(t + 2) * kstep;
            const char* a3 = a2 + kstep; const char* b3 = b2 + kstep;
            if (last && has_next) S.a_ready(nxt);
            if constexpr (SP2) {
            PG8_LDB(B0, 0, 0); PG8_LDB(B1, 0, 1); PG8_SCHED; PG8_LDA(At, 0, 0); PG8_STAGE(PG8_SA(1, 1), a1 + hstep, voffA);
            PG8_WAIT_V(8); PG8_WAIT_L(0); PG8_BAR; PG8_MMA(0, 0, At, B0); PG8_MMA(0, 1, At, B1); PG8_BAR; PG8_SCHED;
            PG8_LDA(At, 0, 1); PG8_STAGE(PG8_SB(0, 0), b2, voffB); PG8_STAGE(PG8_SB(0, 1), b2 + hstep, voffB); PG8_STAGE(PG8_SA(0, 0), a2, voffA);
            PG8_WAIT_V(8); PG8_WAIT_L(0); PG8_BAR; PG8_MMA(1, 0, At, B0); PG8_MMA(1, 1, At, B1); PG8_BAR; PG8_SCHED;
            PG8_LDB(B0, 1, 0); PG8_LDB(B1, 1, 1); PG8_SCHED; PG8_LDA(At, 1, 0); PG8_STAGE(PG8_SA(0, 1), a2 + hstep, voffA);
            PG8_WAIT_V(8); PG8_WAIT_L(0); PG8_BAR; PG8_MMA(0, 0, At, B0); PG8_MMA(0, 1, At, B1); PG8_BAR; PG8_SCHED;
            PG8_LDA(At, 1, 1); PG8_STAGE(PG8_SB(1, 0), b3, voffB); PG8_STAGE(PG8_SB(1, 1), b3 + hstep, voffB); PG8_STAGE(PG8_SA(1, 0), a3, voffA);
            PG8_WAIT_V(8); PG8_WAIT_L(0); PG8_BAR; PG8_MMA(1, 0, At, B0); PG8_MMA(1, 1, At, B1); PG8_BAR; PG8_SCHED;
            } else {
            PG8_LDB(B0, 0, 0); PG8_SCHED; PG8_LDA(At, 0, 0); PG8_STAGE(PG8_SA(1, 1), a1 + hstep, voffA);
            PG8_WAIT_L(8); PG8_BAR; PG8_WAIT_L(0); PG8_MMA(0, 0, At, B0); PG8_BAR; PG8_SCHED;
            PG8_LDB(B1, 0, 1); PG8_STAGE(PG8_SB(0, 0), b2, voffB);
            PG8_BAR; PG8_WAIT_L(0); PG8_MMA(0, 1, At, B1); PG8_BAR;
            PG8_LDA(At, 0, 1); PG8_STAGE(PG8_SA(0, 0), a2, voffA);
            PG8_BAR; PG8_WAIT_L(0); PG8_MMA(1, 0, At, B0); PG8_BAR; PG8_SCHED;
            PG8_STAGE(PG8_SB(0, 1), b2 + hstep, voffB);
            PG8_WAIT_V(6); PG8_BAR; PG8_MMA(1, 1, At, B1); PG8_BAR;
            PG8_LDB(B0, 1, 0); PG8_SCHED; PG8_LDA(At, 1, 0); PG8_STAGE(PG8_SA(0, 1), a2 + hstep, voffA);
            PG8_WAIT_L(8); PG8_BAR; PG8_WAIT_L(0); PG8_MMA(0, 0, At, B0); PG8_BAR; PG8_SCHED;
            PG8_LDB(B1, 1, 1); PG8_STAGE(PG8_SB(1, 0), b3, voffB);
            PG8_BAR; PG8_WAIT_L(0); PG8_MMA(0, 1, At, B1); PG8_BAR;
            PG8_LDA(At, 1, 1); PG8_STAGE(PG8_SA(1, 0), a3, voffA);
            PG8_BAR; PG8_WAIT_L(0); PG8_MMA(1, 0, At, B0); PG8_BAR; PG8_SCHED;
            PG8_STAGE(PG8_SB(1, 1), b3 + hstep, voffB);
            PG8_WAIT_V(6); PG8_BAR; PG8_MMA(1, 1, At, B1); PG8_BAR;
            }
        }
        if constexpr (ALIGN_EPI) { if (wr == 0) PG8_BAR; }
        if constexpr (!Epi::AFTER_DRAIN) { E(acc, cur, wr, wc, fr, fq); S.done(cur); }
        if (!has_next) break;
#pragma unroll
        for (int a = 0; a < 2; ++a)
#pragma unroll
            for (int b = 0; b < 2; ++b)
#pragma unroll
                for (int m = 0; m < 4; ++m)
#pragma unroll
                    for (int n = 0; n < 2; ++n) acc[a][b][m][n] = (f32x4){0.f, 0.f, 0.f, 0.f};
        cur = nxt; cA = nA; cB = nB; ++ui;
        if constexpr (ALIGN_EPI) { if (wr == 1) PG8_BAR; }
    }
    PG8_WAIT_V(0);
    if constexpr (!ALIGN_EPI) { if (wr == 0) PG8_BAR; }
    PG8_BAR;
    if constexpr (Epi::AFTER_DRAIN) { E.fused(acc, cur, wr, wc, fr, fq, lds, wid, lane); S.done(cur); }
#undef PG8_SA
#undef PG8_SB
#undef PG8_STAGE
#undef PG8_LDA
#undef PG8_LDB
#undef PG8_MMA
#undef PG8_WAIT_V
#undef PG8_WAIT_L
#undef PG8_BAR
#undef PG8_SCHED
}
}
namespace attn_body {
using bf16=__hip_bfloat16;
using bf16x8=__attribute__((ext_vector_type(8)))short;
using s16x4=__attribute__((ext_vector_type(4)))short;
using f32x16=__attribute__((ext_vector_type(16)))float;
using u32x4=__attribute__((ext_vector_type(4)))unsigned;
constexpr int D=64,PITCH=2304,OPITCH=1024,RPBATCH=2304;
constexpr int NW=8,QBLK=32,QB=QBLK*NW,KVBLK=64;
constexpr int ATTN_UNIT_ROWS=QB;
__device__ __forceinline__ int crow(int r,int hi){return (r&3)+8*(r>>2)+4*hi;}
#define SBAR() __builtin_amdgcn_sched_barrier(0)
__device__ __forceinline__ void cmask(f32x16&p0,f32x16&p1,int jb,int qrel,int hi){
  const float NEG=-INFINITY; int kb=64*jb+4*hi;
  #pragma unroll
  for(int r=0;r<16;++r){int kv=kb+(r&3)+8*(r>>2); if(kv>qrel)p0[r]=NEG; if(kv+32>qrel)p1[r]=NEG;}
}

template<int CK> __device__ __forceinline__ float sel_ck(float val,int c0,float neg){ int tmp; asm volatile("v_add_u32_e32 %1, %3, %2\n\tv_cmp_gt_u32_e32 vcc, 16, %1\n\tv_cndmask_b32_e32 %0, %4, %0, vcc":"+v"(val),"=&v"(tmp):"v"(c0),"n"(CK),"v"(neg):"vcc"); return val;}
__device__ __forceinline__ void na_mask(f32x16&p0,f32x16&p1,int t,int kr0,int rq,int rs,int cq,int cs,int hi,int h,const float*tab){
  if(t<4)return;
  const float NEG=-INFINITY; const int kr=kr0+t-4;
  if(kr<rs||kr>=rs+8){
    #pragma unroll
    for(int r=0;r<16;++r){p0[r]=NEG;p1[r]=NEG;}
    return; }
  const float*brow=tab+(kr-rq+7)*32+15-cq+4*hi; const int c0=4*hi-cs;
  #define CKOF(r) (((r)&3)+8*((r)>>2))
  #define NA1(r) do{ const float b0=brow[CKOF(r)], b1=brow[CKOF(r)+32]; p0[r]=sel_ck<CKOF(r)>(p0[r]+b0,c0,NEG); p1[r]=sel_ck<CKOF(r)+32>(p1[r]+b1,c0,NEG); }while(0)
  NA1(0);NA1(1);NA1(2);NA1(3); asm volatile("":::"memory");
  NA1(4);NA1(5);NA1(6);NA1(7); asm volatile("":::"memory");
  NA1(8);NA1(9);NA1(10);NA1(11); asm volatile("":::"memory");
  NA1(12);NA1(13);NA1(14);NA1(15);
  #undef NA1
  #undef CKOF
}
constexpr int NSLOT=3, SLOTB=8192;
constexpr int LDS_K=0, LDS_V=NSLOT*SLOTB, LDS_WS=2*NSLOT*SLOTB, LDS_OST=LDS_WS+NW*64*4, LDS_BYTES=LDS_OST+NW*4096;
constexpr float C2=0.125f*1.4426950408889634f;
__device__ __forceinline__ void glds16(const void*gsrc,unsigned lds_dst){unsigned keep;
  asm volatile("s_mov_b32 %0, m0\n\ts_mov_b32 m0, %2\n\ts_nop 0\n\tglobal_load_lds_dwordx4 %1, off\n\ts_mov_b32 m0, %0":"=&s"(keep):"v"(gsrc),"s"(lds_dst):"memory");}
__device__ __forceinline__ void glds16s(const void*sbase,unsigned voff,unsigned lds_dst){unsigned keep;
  asm volatile("s_mov_b32 %0, m0\n\ts_mov_b32 m0, %3\n\ts_nop 0\n\tglobal_load_lds_dwordx4 %1, %2\n\ts_mov_b32 m0, %0":"=&s"(keep):"v"(voff),"s"(sbase),"s"(lds_dst):"memory");}
__device__ __forceinline__ float max3f(float a,float b,float c){float r;asm("v_max3_f32 %0, %1, %2, %3":"=v"(r):"v"(a),"v"(b),"v"(c));return r;}
__device__ __forceinline__ float max2f(float a,float b){float r;asm("v_max_f32_e32 %0, %1, %2":"=v"(r):"v"(a),"v"(b));return r;}
__device__ __forceinline__ float fadd_s(float a,float b){float r;asm("v_add_f32_e32 %0, %1, %2":"=v"(r):"v"(a),"v"(b));return r;}
__device__ __forceinline__ float fsub_s(float a,float b){float r;asm("v_sub_f32_e32 %0, %1, %2":"=v"(r):"v"(a),"v"(b));return r;}
typedef float f32x2_t __attribute__((ext_vector_type(2))); typedef __bf16 bf16x2_t __attribute__((ext_vector_type(2)));
__device__ __forceinline__ unsigned cvtpk_s(float lo,float hi){f32x2_t v={lo,hi};bf16x2_t b=__builtin_convertvector(v,bf16x2_t);return __builtin_bit_cast(unsigned,b);}
#define WAIT_BAR(N) asm volatile("s_waitcnt vmcnt(" #N ") lgkmcnt(0)\n\ts_barrier":::"memory")

__device__ __forceinline__ void qkt(f32x16&p0,f32x16&p1,const char*Kslot,const bf16x8*qr,const f32x16&negm,int r32,int hi){
  const char*kb=Kslot+hi*1024+r32*16;
  #pragma unroll
  for(int d0=0;d0<4;++d0){
    const bf16x8 b0=*reinterpret_cast<const bf16x8*>(kb+d0*2048);
    const bf16x8 b1=*reinterpret_cast<const bf16x8*>(kb+d0*2048+512);
    if(d0==0){p0=__builtin_amdgcn_mfma_f32_32x32x16_bf16(b0,qr[0],negm,0,0,0);p1=__builtin_amdgcn_mfma_f32_32x32x16_bf16(b1,qr[0],negm,0,0,0);}
    else{p0=__builtin_amdgcn_mfma_f32_32x32x16_bf16(b0,qr[d0],p0,0,0,0);p1=__builtin_amdgcn_mfma_f32_32x32x16_bf16(b1,qr[d0],p1,0,0,0);}}
}
typedef __attribute__((address_space(3))) const char* lds_cptr;
typedef short v4i16_t __attribute__((ext_vector_type(4)));
__device__ __forceinline__ void kload8(bf16x8*kf,lds_cptr kp){
  kf[0]=*(const __attribute__((address_space(3))) bf16x8*)(kp);      kf[1]=*(const __attribute__((address_space(3))) bf16x8*)(kp+512);
  kf[2]=*(const __attribute__((address_space(3))) bf16x8*)(kp+2048); kf[3]=*(const __attribute__((address_space(3))) bf16x8*)(kp+2560);
  kf[4]=*(const __attribute__((address_space(3))) bf16x8*)(kp+4096); kf[5]=*(const __attribute__((address_space(3))) bf16x8*)(kp+4608);
  kf[6]=*(const __attribute__((address_space(3))) bf16x8*)(kp+6144); kf[7]=*(const __attribute__((address_space(3))) bf16x8*)(kp+6656);
}
__device__ __forceinline__ void kload2(bf16x8*kf,lds_cptr kp,int j){ kf[2*j]=*(const __attribute__((address_space(3))) bf16x8*)(kp+j*2048); kf[2*j+1]=*(const __attribute__((address_space(3))) bf16x8*)(kp+j*2048+512); }
__device__ __forceinline__ s16x4 vtr(lds_cptr p){ return __builtin_bit_cast(s16x4,__builtin_amdgcn_ds_read_tr16_b64_v4i16((__attribute__((address_space(3))) v4i16_t*)p)); }
__device__ __forceinline__ float rowmax(const f32x16&p0,const f32x16&p1){
  float a=max3f(p0[0],p0[1],p1[0]),b=max3f(p0[2],p0[3],p1[1]);a=max3f(a,p1[2],p1[3]);
  #pragma unroll
  for(int r=4;r<16;r+=4){a=max3f(a,p0[r],p0[r+1]);b=max3f(b,p0[r+2],p0[r+3]);a=max3f(a,p1[r],p1[r+1]);b=max3f(b,p1[r+2],p1[r+3]);}
  const float m=max2f(a,b);
  auto rr=__builtin_amdgcn_permlane32_swap(__float_as_uint(m),__float_as_uint(m),false,false);
  return max2f(__uint_as_float(rr[0]),__uint_as_float(rr[1]));
}
__device__ __forceinline__ void pv(f32x16*o,int vb,bf16x8 pa0,bf16x8 pa1,bf16x8 pa2,bf16x8 pa3){
  #pragma unroll
  for(int d0=0;d0<2;++d0){s16x4 lo[4],hi[4];
    #pragma unroll
    for(int ks=0;ks<4;++ks){
      asm volatile("ds_read_b64_tr_b16 %0,%1 offset:%c2":"=&v"(lo[ks]):"v"(vb),"i"(d0*4096+ks*1024):"memory");
      asm volatile("ds_read_b64_tr_b16 %0,%1 offset:%c2":"=&v"(hi[ks]):"v"(vb),"i"(d0*4096+ks*1024+512):"memory");}
    asm volatile("s_waitcnt lgkmcnt(0)":::"memory");SBAR();
    #define PK(k) (bf16x8){lo[k][0],lo[k][1],lo[k][2],lo[k][3],hi[k][0],hi[k][1],hi[k][2],hi[k][3]}
    o[d0]=__builtin_amdgcn_mfma_f32_32x32x16_bf16(pa0,PK(0),o[d0],0,0,0);
    o[d0]=__builtin_amdgcn_mfma_f32_32x32x16_bf16(pa1,PK(1),o[d0],0,0,0);
    o[d0]=__builtin_amdgcn_mfma_f32_32x32x16_bf16(pa2,PK(2),o[d0],0,0,0);
    o[d0]=__builtin_amdgcn_mfma_f32_32x32x16_bf16(pa3,PK(3),o[d0],0,0,0);
    #undef PK
  }
}

#ifndef ATTN_STORE16
#define ATTN_STORE16(p,v) (*(u32x4*)(p)=(v))
#endif
template<int MODE,int THRL> __device__ __forceinline__ void attn_unit(int b,int q0,int qcol,int kcol,int vcol,int ocol,int tb,int NTin,int kr0,const float*rpbh,const bf16*QKV,bf16*O,char*shm){
  int tid_=threadIdx.x; asm volatile("":"+v"(tid_)); const int tid=tid_,lane=tid&63,r32=lane&31,hi=lane>>5; const int wid=__builtin_amdgcn_readfirstlane(tid>>6);
  const long rowbase=(long)b*RPBATCH;
  const bf16*Qw=QKV+(rowbase+q0+wid*QBLK)*PITCH+qcol;
  const bf16*Kh=QKV+rowbase*PITCH+kcol,*Vh=QKV+rowbase*PITCH+vcol;
  const unsigned lds0=(unsigned)(uintptr_t)shm;
  float*wsf=(float*)(shm+LDS_WS)+wid*64;
  const unsigned koff=(unsigned)(lane*PITCH+wid*8)*2u;
  const unsigned voffv=(unsigned)((16*(wid&3)+(lane>>2))*PITCH+(wid>>2)*32+(lane&3)*8)*2u;
  const unsigned kdst=lds0+LDS_K+wid*1024, vdst=lds0+LDS_V+wid*1024;
  #define TROW(t) ((MODE==1)?(((t)<4)?(2048+64*(t)):(64*(kr0+(t)-4))):(tb+64*(t)))
  #define DMA_K(t,slot) glds16s(Kh+(long)TROW(t)*PITCH,koff,(unsigned)__builtin_amdgcn_readfirstlane(kdst+(slot)))
  #define DMA_V(t,slot) glds16s(Vh+(long)TROW(t)*PITCH,voffv,(unsigned)__builtin_amdgcn_readfirstlane(vdst+(slot)))
  const int vb0=(int)(lds0+LDS_V)+((lane>>4)&1)*32+(lane&3)*8+(4*hi+((lane&15)>>2))*64;
  const char*Kbase=shm+LDS_K; bf16x8 kf[8];
  const lds_cptr shm3=(lds_cptr)shm; const lds_cptr kp0=shm3+LDS_K+hi*1024+r32*16; const lds_cptr vp0=shm3+LDS_V+((lane>>4)&1)*32+(lane&3)*8+(4*hi+((lane&15)>>2))*64;
  const int NT=(MODE==1)?16:NTin;
  const int rq=(q0>>6)+(wid>>1), cq=(wid&1)*32+r32; const int rs=min(max(rq-4,0),24), cs=min(max(cq-8,0),48);
  float*tab=(float*)(shm+LDS_BYTES);
  if(MODE==1){ for(int i=tid;i<15*32;i+=NW*64){const int ii=i>>5,jj=i&31; tab[i]=(jj<31)?rpbh[ii*31+jj]*1.4426950408889634f:0.f;} }
  DMA_K(0,0);DMA_V(0,0);DMA_K(1,SLOTB);
  bf16x8 qr[4];
  #pragma unroll
  for(int d0=0;d0<4;++d0)qr[d0]=*reinterpret_cast<const bf16x8*>(&Qw[(long)r32*PITCH+d0*16+hi*8]);
  float mhat=0.f,l_reg=0.f;f32x16 o[2];o[0]=f32x16{};o[1]=f32x16{};const f32x16 negm=f32x16{};
  const int qrel=wid*QBLK+r32;
  #define CMASK(P0,P1,t) do{ if(MODE==1) na_mask(P0,P1,(t),kr0,rq,rs,cq,cs,hi,wid&1,tab); }while(0)
  bool resc=false;
  #define START(P0,P1) do{ const float rm=rowmax(P0,P1); resc=false; \
    { const float dl=rm; mhat=fadd_s(mhat,dl); \
      _Pragma("unroll") for(int r=0;r<16;++r){P0[r]=fsub_s(P0[r],dl);P1[r]=fsub_s(P1[r],dl);} \
      } \
    _Pragma("unroll") for(int r=0;r<16;++r)P0[r]=__builtin_amdgcn_exp2f(P0[r]); }while(0)
  #define RESC() do{ if(resc){ asm volatile("s_waitcnt lgkmcnt(0)":::"memory"); \
      _Pragma("unroll") for(int d_=0;d_<2;++d_) _Pragma("unroll") for(int r=0;r<16;++r)o[d_][r]*=wsf[crow(r,hi)]; } }while(0)
  f32x16 pA0,pA1,pB0,pB1;
  int sl_prev=0,sl_cur=0,sl_next=SLOTB;
  #define ROT() do{sl_prev=sl_cur;sl_cur=sl_next;sl_next=(sl_next==(NSLOT-1)*SLOTB)?0:sl_next+SLOTB;}while(0)
  DMA_K(2,2*SLOTB);
  WAIT_BAR(3);
  qkt(pA0,pA1,Kbase,qr,negm,r32,hi);asm volatile("s_nop 15\n\ts_nop 7":"+v"(pA0),"+v"(pA1));CMASK(pA0,pA1,0);
  START(pA0,pA1);
  _Pragma("unroll") for(int r=0;r<16;++r)pA1[r]=__builtin_amdgcn_exp2f(pA1[r]);
  WAIT_BAR(0);
  DMA_K(3,0);DMA_V(1,SLOTB);
  ROT();
  kload8(kf,kp0+sl_cur);
  WAIT_BAR(2);
  s16x4 vlo[8],vhi[8]; u32x4 pw0,pw1,pw2,pw3;
  #define PKW(P,B) cvtpk_s(P[B],P[B+1])
  #define PAF(k) __builtin_bit_cast(bf16x8,pw##k)
  #define VFR(i) (bf16x8){vlo[i][0],vlo[i][1],vlo[i][2],vlo[i][3],vhi[i][0],vhi[i][1],vhi[i][2],vhi[i][3]}
  #define PIN(x) asm volatile("":"+v"(x))
  #define MX3(a,b,c) __builtin_fmaxf(__builtin_fmaxf((a),(b)),(c))
  #define GAPA(MF,A0,A1,A2,A3,W0,W1,PW) do{ MF; sacc+=A0; sacc+=A1; sacc+=A2; sacc+=A3; PIN(sacc); W0; W1; PIN(PW); SBAR(); }while(0)
  #define EX(v) __builtin_amdgcn_exp2f(v)
  #define GAPB(MF,X,B) do{ MF; X[B]=EX(X[B]); X[B+1]=EX(X[B+1]); X[B+2]=EX(X[B+2]); X[B+3]=EX(X[B+3]); PIN(X); SBAR(); }while(0)
  #define VRD(i) do{ vlo[i]=vtr(vp_+(((i)>>2)*4096+((i)&3)*1024)); vhi[i]=vtr(vp_+(((i)>>2)*4096+((i)&3)*1024+512)); }while(0)
  #define KRD(G,j) do{ if(G){ kload2(kf,kp0+sl_next,j); SBAR(); } }while(0)
  #define STEP(C0,C1,P0,P1,t,GK,GV,GL) do{ SBAR(); \
    const lds_cptr vp_=vp0+sl_prev; \
    VRD(0); SBAR(); float sacc=(P0[0]+P0[1]); \
    GAPA(C0=__builtin_amdgcn_mfma_f32_32x32x16_bf16(kf[0],qr[0],negm,0,0,0), P0[2],P0[3],P0[4],P0[5],     pw0[0]=PKW(P0,0), pw0[1]=PKW(P0,2), pw0); \
    VRD(4); SBAR(); GAPA(C1=__builtin_amdgcn_mfma_f32_32x32x16_bf16(kf[1],qr[0],negm,0,0,0), P0[6],P0[7],P0[8],P0[9],     pw0[2]=PKW(P0,4), pw0[3]=PKW(P0,6), pw0); \
    VRD(1); SBAR(); GAPA(C0=__builtin_amdgcn_mfma_f32_32x32x16_bf16(kf[2],qr[1],C0,0,0,0),   P0[10],P0[11],P0[12],P0[13], pw1[0]=PKW(P0,8), pw1[1]=PKW(P0,10), pw1); \
    VRD(5); SBAR(); GAPA(C1=__builtin_amdgcn_mfma_f32_32x32x16_bf16(kf[3],qr[1],C1,0,0,0),   P0[14],P0[15],P1[0],P1[1],   pw1[2]=PKW(P0,12),pw1[3]=PKW(P0,14), pw1); \
    VRD(2); SBAR(); GAPA(C0=__builtin_amdgcn_mfma_f32_32x32x16_bf16(kf[4],qr[2],C0,0,0,0),   P1[2],P1[3],P1[4],P1[5],     pw2[0]=PKW(P1,0), pw2[1]=PKW(P1,2), pw2); \
    VRD(6); SBAR(); GAPA(C1=__builtin_amdgcn_mfma_f32_32x32x16_bf16(kf[5],qr[2],C1,0,0,0),   P1[6],P1[7],P1[8],P1[9],     pw2[2]=PKW(P1,4), pw2[3]=PKW(P1,6), pw2); \
    VRD(3); SBAR(); GAPA(C0=__builtin_amdgcn_mfma_f32_32x32x16_bf16(kf[6],qr[3],C0,0,0,0),   P1[10],P1[11],P1[12],P1[13], pw3[0]=PKW(P1,8), pw3[1]=PKW(P1,10), pw3); \
    VRD(7); SBAR(); GAPA(C1=__builtin_amdgcn_mfma_f32_32x32x16_bf16(kf[7],qr[3],C1,0,0,0),   P1[14],P1[15],0.f,0.f,       pw3[2]=PKW(P1,12),pw3[3]=PKW(P1,14), pw3); \
    l_reg+=sacc; \
    if(GK){DMA_K((t)+3,sl_cur);} if(GV){DMA_V((t)+1,sl_next);} \
    _Pragma("unroll") for(int r=0;r<16;++r){C0[r]-=mhat;C1[r]-=mhat;} \
    CMASK(C0,C1,t); \
    { float a=MX3(C0[0],C0[1],C1[0]),b=MX3(C0[2],C0[3],C1[1]); a=MX3(a,C1[2],C1[3]); \
      _Pragma("unroll") for(int r=4;r<16;r+=4){a=MX3(a,C0[r],C0[r+1]);b=MX3(b,C0[r+2],C0[r+3]);a=MX3(a,C1[r],C1[r+1]);b=MX3(b,C1[r+2],C1[r+3]);} \
      float rm=__builtin_fmaxf(a,b); { auto rr=__builtin_amdgcn_permlane32_swap(__float_as_uint(rm),__float_as_uint(rm),false,false); rm=__builtin_fmaxf(__uint_as_float(rr[0]),__uint_as_float(rr[1])); } \
      resc=false; \
      if(__builtin_expect(__any(rm>(float)THRL),0)){ const float dl=__builtin_fmaxf(rm,0.f); mhat+=dl; \
        _Pragma("unroll") for(int r=0;r<16;++r){C0[r]-=dl;C1[r]-=dl;} \
        const float f=__builtin_amdgcn_exp2f(-dl); l_reg*=f; if(hi==0)wsf[r32]=f; resc=true; } } \
    SBAR(); \
    GAPB(o[0]=__builtin_amdgcn_mfma_f32_32x32x16_bf16(PAF(0),VFR(0),o[0],0,0,0), C0,0); \
    GAPB(o[1]=__builtin_amdgcn_mfma_f32_32x32x16_bf16(PAF(0),VFR(4),o[1],0,0,0), C0,4); \
    KRD(GL,0); GAPB(o[0]=__builtin_amdgcn_mfma_f32_32x32x16_bf16(PAF(1),VFR(1),o[0],0,0,0), C0,8); \
    KRD(GL,1); GAPB(o[1]=__builtin_amdgcn_mfma_f32_32x32x16_bf16(PAF(1),VFR(5),o[1],0,0,0), C0,12); \
    KRD(GL,2); GAPB(o[0]=__builtin_amdgcn_mfma_f32_32x32x16_bf16(PAF(2),VFR(2),o[0],0,0,0), C1,0); \
    KRD(GL,3); GAPB(o[1]=__builtin_amdgcn_mfma_f32_32x32x16_bf16(PAF(2),VFR(6),o[1],0,0,0), C1,4); \
    GAPB(o[0]=__builtin_amdgcn_mfma_f32_32x32x16_bf16(PAF(3),VFR(3),o[0],0,0,0), C1,8); \
    GAPB(o[1]=__builtin_amdgcn_mfma_f32_32x32x16_bf16(PAF(3),VFR(7),o[1],0,0,0), C1,12); \
    }while(0)
  int t=1;
  _Pragma("nounroll") for(;t+5<NT;t+=2){
    STEP(pB0,pB1,pA0,pA1,t,true,true,true);     WAIT_BAR(2); RESC(); ROT();
    STEP(pA0,pA1,pB0,pB1,t+1,true,true,true);   WAIT_BAR(2); RESC(); ROT();
  }
  #define ENDW(tt) do{ if((tt)+3<NT){WAIT_BAR(2);} else if((tt)+2<NT){WAIT_BAR(1);} else {WAIT_BAR(0);} }while(0)
  _Pragma("nounroll") for(;t+1<NT;t+=2){
    STEP(pB0,pB1,pA0,pA1,t,(t+3<NT),(t+1<NT),(t+1<NT));       ENDW(t);   RESC(); ROT();
    STEP(pA0,pA1,pB0,pB1,t+1,(t+4<NT),(t+2<NT),(t+2<NT));     ENDW(t+1); RESC(); ROT();
  }
  STEP(pB0,pB1,pA0,pA1,NT-1,false,false,false); RESC();
  { float sacc=pB0[0]+pB0[1]; _Pragma("unroll") for(int r=2;r<16;++r)sacc+=pB0[r]; _Pragma("unroll") for(int r=0;r<16;++r)sacc+=pB1[r]; l_reg+=sacc;
    pw0=(u32x4){PKW(pB0,0),PKW(pB0,2),PKW(pB0,4),PKW(pB0,6)};pw1=(u32x4){PKW(pB0,8),PKW(pB0,10),PKW(pB0,12),PKW(pB0,14)};pw2=(u32x4){PKW(pB1,0),PKW(pB1,2),PKW(pB1,4),PKW(pB1,6)};pw3=(u32x4){PKW(pB1,8),PKW(pB1,10),PKW(pB1,12),PKW(pB1,14)};
    SBAR(); pv(o,vb0+sl_cur,PAF(0),PAF(1),PAF(2),PAF(3)); }
  #undef PKW
  #undef PAF
  #undef VFR
  #undef PIN
  #undef MX3
  #undef GAPA
  #undef GAPB
  #undef EX
  #undef VRD
  #undef KRD
  #undef STEP
  #undef ENDW
  {auto rr=__builtin_amdgcn_permlane32_swap(__float_as_uint(l_reg),__float_as_uint(l_reg),false,false);l_reg=__uint_as_float(rr[0])+__uint_as_float(rr[1]);}
  if(hi==0)wsf[32+r32]=l_reg;asm volatile("s_waitcnt lgkmcnt(0)":::"memory");
  float rli[16];
  #pragma unroll
  for(int r=0;r<16;++r)rli[r]=__builtin_amdgcn_rcpf(wsf[32+crow(r,hi)]);
  bf16*Ow=O+(rowbase+q0+wid*QBLK)*OPITCH+ocol;
  { bf16*stg=(bf16*)(shm+LDS_OST)+wid*2048;
    #pragma unroll
    for(int r=0;r<16;++r){const int orow=crow(r,hi);
      #pragma unroll
      for(int d0=0;d0<2;++d0)stg[orow*64+d0*32+r32]=__float2bfloat16(o[d0][r]*rli[r]);}
    asm volatile("s_waitcnt lgkmcnt(0)":::"memory");
    #pragma unroll
    for(int i=0;i<4;++i){const int row=i*8+(lane>>3),ch=lane&7; const u32x4 v=*(const u32x4*)(stg+row*64+ch*8); ATTN_STORE16(Ow+(long)row*OPITCH+ch*8,v);} }
  asm volatile("s_waitcnt lgkmcnt(0)\n\ts_barrier":::"memory");
  #undef DMA_K
  #undef TROW
  #undef DMA_V
  #undef CMASK
  #undef START
  #undef RESC
  #undef ROT
}
constexpr int ATTN_LDS_BYTES=LDS_BYTES+2048;
#undef SBAR
#undef WAIT_BAR
}
constexpr int NWAVES = 8;
constexpr int DMODEL = 1024, NBATCH = 8, SEQL = 2048, CTXL = 256, RPB = SEQL + CTXL  , MROWS = NBATCH * RPB  ;
constexpr int DFF = 2816, N13 = 2 * DFF, NIN = 2304, NMOD = 9, MODW = NMOD * DMODEL;
constexpr float EPS = 1e-6f;
constexpr float QC2 = 0.125f * 1.4426950408889634f;
constexpr size_t MiB = 1u << 20;
constexpr size_t WS_CTL = 0, CTL_ZERO_BYTES = 1 * MiB;
constexpr size_t WS_MODS = 1 * MiB;
constexpr size_t WS_ROPE = 2 * MiB;
constexpr size_t WS_W = 3 * MiB;
constexpr size_t SZ_W13 = (size_t)N13 * DMODEL * 2, SZ_W2 = (size_t)DMODEL * DFF * 2, SZ_WIN = (size_t)NIN * DMODEL * 2, SZ_WOUT = (size_t)DMODEL * DMODEL * 2;
constexpr size_t OFF_W13A = 0, OFF_W2A = OFF_W13A + SZ_W13, OFF_WIN = OFF_W2A + SZ_W2, OFF_WOUT = OFF_WIN + SZ_WIN, OFF_W13B = OFF_WOUT + SZ_WOUT, OFF_W2B = OFF_W13B + SZ_W13, SZ_WLAYER = OFF_W2B + SZ_W2;
constexpr size_t WS_XS = WS_W + 2 * SZ_WLAYER;
constexpr size_t WS_U = WS_XS + (size_t)MROWS * DMODEL * 4;
constexpr size_t WS_O = WS_U + (size_t)MROWS * DFF * 2;
constexpr size_t WS_END = WS_O + (size_t)MROWS * DMODEL * 2;
static_assert(WS_O == WS_O_BYTES && WS_END == WS_END_BYTES && WS_U == WS_U_BYTES, "slab offsets");
static_assert(WS_XS % 256 == 0 && WS_U % 256 == 0 && WS_O % 256 == 0, "alignment");
constexpr int CW_BAR = 4096;
constexpr int RING_BYTES = 131072, LDSCTL_OFF = RING_BYTES, MISC_OFF = LDSCTL_OFF + 320, LDS_BYTES = 147456;

#define GAS __attribute__((address_space(1)))
#define LAS __attribute__((address_space(3)))
typedef unsigned short bf16;
typedef unsigned v4u __attribute__((ext_vector_type(4)));
typedef unsigned v2u __attribute__((ext_vector_type(2)));
typedef float f32x4 __attribute__((ext_vector_type(4)));
typedef float f32x2 __attribute__((ext_vector_type(2)));
#define LDS_WAIT() asm volatile("s_waitcnt lgkmcnt(0)" ::: "memory")
__device__ __forceinline__ unsigned f2bf(float f) { unsigned u = __builtin_bit_cast(unsigned, f); return (u + 0x7fffu + ((u >> 16) & 1u)) >> 16; }
__device__ __forceinline__ unsigned pk2(float lo, float hi) { return f2bf(lo) | (f2bf(hi) << 16); }
__device__ __forceinline__ float bf2f(unsigned short h) { return __builtin_bit_cast(float, (unsigned)h << 16); }
__device__ __forceinline__ float wave_sum(float v) {
#pragma unroll
    for (int o = 1; o < 64; o <<= 1) v += __shfl_xor(v, o);
    return v;
}
#define RLX_AGENT __ATOMIC_RELAXED, __HIP_MEMORY_SCOPE_AGENT
#define XB_TMO      128
#define XB_XCNT(j)  (256  + 64 * (j))
#define XB_XSUB(j)  (1280 + 64 * (j))
#define XB_XGEN(j)  (2304 + 64 * (j))
#define XB_TOP      3328
#define XB_TOPGEN   3392
#define XCD_BAR_WORDS 3456
#define XB_SPIN_CAP (1u << 18)

__device__ __forceinline__ unsigned xb_ld(unsigned* p)              { return __hip_atomic_load(p, __ATOMIC_RELAXED, __HIP_MEMORY_SCOPE_AGENT); }
__device__ __forceinline__ unsigned xb_add(unsigned* p, unsigned v) { return __hip_atomic_fetch_add(p, v, __ATOMIC_RELAXED, __HIP_MEMORY_SCOPE_AGENT); }
__device__ __forceinline__ unsigned xb_xcc_id() { return (unsigned)__builtin_amdgcn_s_getreg((3 << 11) | 20) & 0xFu; }
#define XB_SPIN(cond, bar) do { unsigned _sp = 0; while (cond) { __builtin_amdgcn_s_sleep(1); \
    if ((++_sp & 255u) == 0u) { if (xb_ld(&(bar)[XB_TMO])) break; if (_sp > XB_SPIN_CAP) { atomicAdd(&(bar)[XB_TMO], 1u); break; } } } } while (0)

struct XcdBarrier {
    unsigned* bar; unsigned x;
    volatile LAS unsigned* st;
};

__device__ __forceinline__ XcdBarrier xcd_barrier_post(unsigned* bar, volatile LAS unsigned* st) {
    XcdBarrier b; b.bar = bar; b.x = xb_xcc_id(); b.st = st;
    if (threadIdx.x == 0) (void)xb_add(&bar[XB_XCNT(b.x)], 1u);
    return b;
}
__device__ __forceinline__ void xcd_barrier_complete(unsigned* bar, unsigned x, unsigned& nloc, unsigned& nx) {
    const unsigned G = gridDim.x * gridDim.y * gridDim.z;
    unsigned sum, cnt, mine, sp = 0u;
    for (;;) {
        sum = 0u; cnt = 0u; mine = 0u;
#pragma unroll
        for (unsigned j = 0; j < 16; ++j) { const unsigned c = xb_ld(&bar[XB_XCNT(j)]); sum += c; cnt += (c > 0u) ? 1u : 0u; mine = (j == x) ? c : mine; }
        if (sum == G) break;
        __builtin_amdgcn_s_sleep(1);
        if ((++sp & 255u) == 0u) { if (xb_ld(&bar[XB_TMO])) break; if (sp > XB_SPIN_CAP) { atomicAdd(&bar[XB_TMO], 1u); break; } }
    }
    nloc = mine > 0u ? mine : 1u; nx = cnt > 0u ? cnt : 1u;
}

__device__ __forceinline__ void xcd_barrier(const XcdBarrier& b) {
    asm volatile("s_waitcnt vmcnt(0)" ::: "memory");
    __syncthreads();
    if (threadIdx.x == 0) {
        unsigned* bar = b.bar;
        __builtin_amdgcn_s_waitcnt(0);
        unsigned nloc = b.st[0], nx = b.st[1];
        if (nloc == 0u) { xcd_barrier_complete(bar, b.x, nloc, nx); b.st[0] = nloc; b.st[1] = nx; }
        const unsigned old = xb_add(&bar[XB_XSUB(b.x)], 1u);
        const unsigned gen = old / nloc;
        if (old + 1u == (gen + 1u) * nloc) {
            __builtin_amdgcn_fence(__ATOMIC_RELEASE, "agent");
            asm volatile("s_waitcnt vmcnt(0)" ::: "memory");
            const unsigned og = xb_add(&bar[XB_TOP], 1u);
            const unsigned tg = og / nx;
            if (og + 1u == (tg + 1u) * nx) xb_add(&bar[XB_TOPGEN], 1u);
            else XB_SPIN(xb_ld(&bar[XB_TOPGEN]) == tg, bar);
            __builtin_amdgcn_fence(__ATOMIC_ACQUIRE, "agent");
            xb_add(&bar[XB_XGEN(b.x)], 1u);
            asm volatile("s_waitcnt vmcnt(0)" ::: "memory");
        } else {
            XB_SPIN(xb_ld(&bar[XB_XGEN(b.x)]) == gen, bar);
            __builtin_amdgcn_fence(__ATOMIC_ACQUIRE, "agent");
            asm volatile("s_waitcnt vmcnt(0)" ::: "memory");
        }
    }
    __syncthreads();
}
struct Args {
    const float* in[21]; float* out; unsigned char* ws; int pad0, pad1;
};
typedef const __attribute__((address_space(4))) Args* ArgsP;
__device__ __forceinline__ ArgsP get_args() { ArgsP p = (ArgsP)__builtin_amdgcn_kernarg_segment_ptr(); asm volatile("" : "+s"(p)); return p; }
struct Frame {
    LAS unsigned char* lds; int tid, lane, wave, vcu, G;
    __device__ __forceinline__ void refresh() { int t = threadIdx.x; asm volatile("" : "+v"(t)); tid = t; lane = t & 63; wave = __builtin_amdgcn_readfirstlane(t >> 6); }
};
template <int MAP> __device__ __forceinline__ int map_dest(int s) {
    if (MAP == 1) { const int bj = s >= DFF ? 1 : 0, r = s - bj * DFF; return (r >> 7) * 256 + bj * 128 + (r & 127); }
    if (MAP == 2) { const int pn = s >> 8, rem = s & 255, wc = rem >> 6, bj = (rem >> 5) & 1, nn = (rem >> 4) & 1, fq = (rem >> 2) & 3, e = rem & 3; return pn * 256 + bj * 128 + wc * 32 + fq * 8 + nn * 4 + e; }
    return s;
}
template <int MAP> __device__ __forceinline__ void p0_transpose_item(const float* W, int K, int N, bf16* WT, LAS float* scr, int item, int lane) {
    const int nblk = N / 32, kb = item / nblk, nb = item % nblk, k0 = 64 * kb, n0 = 32 * nb;
#pragma unroll 8
    for (int i = 0; i < 32; ++i) { const int kk = 2 * i + (lane >> 5); scr[kk * 33 + (lane & 31)] = W[(size_t)(k0 + kk) * N + n0 + (lane & 31)]; }
    LDS_WAIT(); asm volatile("" ::: "memory");
    const int c = lane & 7;
#pragma unroll
    for (int j = 0; j < 4; ++j) { const int n = (lane >> 3) + 8 * j; const LAS float* s = scr + (8 * c) * 33 + n;
        v4u o; o.x = pk2(s[0 * 33], s[1 * 33]); o.y = pk2(s[2 * 33], s[3 * 33]); o.z = pk2(s[4 * 33], s[5 * 33]); o.w = pk2(s[6 * 33], s[7 * 33]);
        *(GAS v4u*)(WT + (size_t)map_dest<MAP>(n0 + n) * K + k0 + 8 * c) = o; }
    LDS_WAIT(); asm volatile("" ::: "memory");
}
__device__ __forceinline__ void p0_mod_unit(const Frame& F, int unit, const float* c, const float* cctx, const float* wmod, const float* bmod, float* mods) {
    const int layer = unit / 72, col0 = (unit % 72) * 128;
    LAS float* sc = (LAS float*)F.lds;
    LAS float* red = sc + 9 * 1024;
    for (int i = F.tid; i < 9 * 1024; i += NWAVES * 64) { const int j = i >> 10, k = i & 1023; const float v = j < 8 ? c[j * 1024 + k] : cctx[k]; sc[i] = v / (1.0f + expf(-v)); }
    __syncthreads();
    const float* W = wmod + (size_t)layer * 1024 * MODW + col0 + 2 * F.lane;
    float a0[9], a1[9];
#pragma unroll
    for (int j = 0; j < 9; ++j) { a0[j] = 0.f; a1[j] = 0.f; }
    const int kw = F.wave * 128;
    for (int kk = 0; kk < 128; kk += 8) {
        f32x2 w[8];
#pragma unroll
        for (int q = 0; q < 8; ++q) w[q] = *(const f32x2*)(W + (size_t)(kw + kk + q) * MODW);
#pragma unroll
        for (int q = 0; q < 8; ++q)
#pragma unroll
            for (int j = 0; j < 9; ++j) { const float s = sc[j * 1024 + kw + kk + q]; a0[j] += s * w[q].x; a1[j] += s * w[q].y; }
    }
#pragma unroll
    for (int j = 0; j < 9; ++j) { red[(F.wave * 9 + j) * 128 + 2 * F.lane] = a0[j]; red[(F.wave * 9 + j) * 128 + 2 * F.lane + 1] = a1[j]; }
    __syncthreads();
    for (int i = F.tid; i < 9 * 128; i += NWAVES * 64) { const int j = i >> 7, cc = i & 127; float s = 0.f;
#pragma unroll
        for (int w = 0; w < 8; ++w) s += red[(w * 9 + j) * 128 + cc];
        mods[(size_t)(layer * 9 + j) * MODW + col0 + cc] = s + bmod[layer * MODW + col0 + cc]; }
    __syncthreads();
}
__device__ __forceinline__ void p0_prologue(Frame F, ArgsP A) {
    F.refresh();
    unsigned char* ws = A->ws;
    if ((int)blockIdx.x < 144) p0_mod_unit(F, (int)blockIdx.x, A->in[1], A->in[3], A->in[4], A->in[5], (float*)(ws + WS_MODS));
    if ((int)blockIdx.x == F.G - 1) {
        float* rc = (float*)(ws + WS_ROPE); float* rs = rc + 1024;
        for (int i = F.tid; i < 1024; i += NWAVES * 64) { const int pos = i >> 4, fi = i & 15; const float inv = powf(10000.0f, -(float)(2 * fi) / 32.0f); const float ang = (float)pos * inv; rc[i] = cosf(ang); rs[i] = sinf(ang); }
    }
    LAS float* scr = (LAS float*)(F.lds + F.wave * 16384);
    const int gw = F.vcu * NWAVES + F.wave, NGW = F.G * NWAVES;
    constexpr int I13 = (DMODEL / 64) * (N13 / 32), I2 = (DFF / 64) * (DMODEL / 32), IIN = (DMODEL / 64) * (NIN / 32), IOUT = (DMODEL / 64) * (DMODEL / 32);
    constexpr int ILAYER = 2 * I13 + 2 * I2 + IIN + IOUT;
    for (int it = gw; it < 2 * ILAYER; it += NGW) {
        const int l = it / ILAYER; int r = it % ILAYER;
        unsigned char* wl = ws + WS_W + (size_t)l * SZ_WLAYER;
        if (r < I13) { p0_transpose_item<1>(A->in[7] + (size_t)l * DMODEL * N13, DMODEL, N13, (bf16*)(wl + OFF_W13A), scr, r, F.lane); continue; } r -= I13;
        if (r < I13) { p0_transpose_item<1>(A->in[18] + (size_t)l * DMODEL * N13, DMODEL, N13, (bf16*)(wl + OFF_W13B), scr, r, F.lane); continue; } r -= I13;
        if (r < I2) { p0_transpose_item<0>(A->in[8] + (size_t)l * DFF * DMODEL, DFF, DMODEL, (bf16*)(wl + OFF_W2A), scr, r, F.lane); continue; } r -= I2;
        if (r < I2) { p0_transpose_item<0>(A->in[19] + (size_t)l * DFF * DMODEL, DFF, DMODEL, (bf16*)(wl + OFF_W2B), scr, r, F.lane); continue; } r -= I2;
        if (r < IIN) { p0_transpose_item<2>(A->in[10] + (size_t)l * DMODEL * NIN, DMODEL, NIN, (bf16*)(wl + OFF_WIN), scr, r, F.lane); continue; } r -= IIN;
        p0_transpose_item<0>(A->in[16] + (size_t)l * DMODEL * DMODEL, DMODEL, DMODEL, (bf16*)(wl + OFF_WOUT), scr, r, F.lane);
    }
}
__device__ __forceinline__ void modnorm_phase(Frame F, ArgsP A, bool first, bool latent_only, int combine  , const float* g, const float* modl  , int chunk_shift) {
    F.refresh();
    float* xs = (float*)(A->ws + WS_XS); bf16* H = (bf16*)A->out;
    const int gw = F.vcu * NWAVES + F.wave, NGW = F.G * NWAVES;
    for (int row = gw; row < MROWS; row += NGW) {
        const int b = row / RPB, t = row - b * RPB; const bool isctx = t >= SEQL; const int j = isctx ? 8 : b;
        if (isctx && latent_only) continue;
        const float* src = first ? (isctx ? A->in[2] + (size_t)(b * CTXL + t - SEQL) * DMODEL : A->in[0] + (size_t)(b * SEQL + t) * DMODEL) : xs + (size_t)row * DMODEL;
        const GAS f32x4* xr = (const GAS f32x4*)src + F.lane;
        f32x4 v[4]; float s2 = 0.f;
#pragma unroll
        for (int q = 0; q < 4; ++q) { v[q] = xr[64 * q]; s2 += (v[q].x * v[q].x + v[q].y * v[q].y) + (v[q].z * v[q].z + v[q].w * v[q].w); }
        if (combine && row >= 16384) {
#pragma unroll
            for (int ch = 0; ch < 8; ++ch) { const GAS f32x4* pr = (const GAS f32x4*)(pg8::part_slab(A->ws, (unsigned char*)A->out, ch, combine == 2) + (size_t)(row - 16384) * DMODEL) + F.lane;
#pragma unroll
                for (int q = 0; q < 4; ++q) v[q] = v[q] + pr[64 * q]; }
            s2 = 0.f; GAS f32x4* xo = (GAS f32x4*)(xs + (size_t)row * DMODEL) + F.lane;
#pragma unroll
            for (int q = 0; q < 4; ++q) { xo[64 * q] = v[q]; s2 += (v[q].x * v[q].x + v[q].y * v[q].y) + (v[q].z * v[q].z + v[q].w * v[q].w); }
        }
        const float rstd = 1.0f / sqrtf(wave_sum(s2) * (1.0f / DMODEL) + EPS);
        const float* sh = modl + (size_t)j * MODW + chunk_shift * DMODEL; const float* scl = sh + DMODEL;
        if (first) { GAS f32x4* xo = (GAS f32x4*)(xs + (size_t)row * DMODEL) + F.lane;
#pragma unroll
            for (int q = 0; q < 4; ++q) xo[64 * q] = v[q]; }
        GAS unsigned long long* o8 = (GAS unsigned long long*)(H + (size_t)row * DMODEL) + F.lane;
#pragma unroll
        for (int q = 0; q < 4; ++q) { const int col = 4 * F.lane + 256 * q;
            const f32x4 gg = *(const f32x4*)(g + col), sc = *(const f32x4*)(scl + col), sf = *(const f32x4*)(sh + col);
            const f32x4 h = v[q] * rstd * gg * (sc + 1.0f) + sf;
            o8[64 * q] = (unsigned long long)pk2(h.x, h.y) | ((unsigned long long)pk2(h.z, h.w) << 32); }
    }
}
__device__ __forceinline__ void onorm_phase(Frame F, ArgsP A, bool latent_only, const float* ga, const float* gb) {
    F.refresh();
    bf16* O = (bf16*)(A->ws + WS_O);
    const int gw = F.vcu * NWAVES + F.wave, NGW = F.G * NWAVES;
    for (int row = gw; row < MROWS; row += NGW) {
        const int t = row % RPB; if (t >= SEQL && latent_only) continue;
        GAS v4u* p = (GAS v4u*)(O + (size_t)row * DMODEL) + F.lane;
        v4u wa = p[0], wb = p[64]; float xa[8], xb[8]; float sa = 0.f, sb = 0.f;
#pragma unroll
        for (int q = 0; q < 4; ++q) { xa[2 * q] = __builtin_bit_cast(float, wa[q] << 16); xa[2 * q + 1] = __builtin_bit_cast(float, wa[q] & 0xffff0000u);
            xb[2 * q] = __builtin_bit_cast(float, wb[q] << 16); xb[2 * q + 1] = __builtin_bit_cast(float, wb[q] & 0xffff0000u); }
#pragma unroll
        for (int q = 0; q < 8; ++q) { sa += xa[q] * xa[q]; sb += xb[q] * xb[q]; }
        const float ra = 1.0f / sqrtf(wave_sum(sa) * (1.0f / 512.0f) + EPS), rb = 1.0f / sqrtf(wave_sum(sb) * (1.0f / 512.0f) + EPS);
        const f32x4 a0 = *(const f32x4*)(ga + 8 * F.lane), a1 = *(const f32x4*)(ga + 8 * F.lane + 4), b0 = *(const f32x4*)(gb + 8 * F.lane), b1 = *(const f32x4*)(gb + 8 * F.lane + 4);
        v4u oa, ob;
        oa.x = pk2(xa[0] * ra * a0.x, xa[1] * ra * a0.y); oa.y = pk2(xa[2] * ra * a0.z, xa[3] * ra * a0.w); oa.z = pk2(xa[4] * ra * a1.x, xa[5] * ra * a1.y); oa.w = pk2(xa[6] * ra * a1.z, xa[7] * ra * a1.w);
        ob.x = pk2(xb[0] * rb * b0.x, xb[1] * rb * b0.y); ob.y = pk2(xb[2] * rb * b0.z, xb[3] * rb * b0.w); ob.z = pk2(xb[4] * rb * b1.x, xb[5] * rb * b1.y); ob.w = pk2(xb[6] * rb * b1.z, xb[7] * rb * b1.w);
        p[0] = oa; p[64] = ob;
    }
}
__device__ __forceinline__ void final_phase(Frame F, ArgsP A) {
    F.refresh();
    const float* xs = (const float*)(A->ws + WS_XS); const float* g = A->in[20];
    const int gw = F.vcu * NWAVES + F.wave, NGW = F.G * NWAVES;
    for (int r = gw; r < NBATCH * SEQL; r += NGW) {
        const int b = r / SEQL, t = r - b * SEQL;
        const GAS f32x4* xr = (const GAS f32x4*)(xs + (size_t)(b * RPB + t) * DMODEL) + F.lane;
        f32x4 v[4]; float s2 = 0.f;
#pragma unroll
        for (int q = 0; q < 4; ++q) { v[q] = xr[64 * q]; s2 += (v[q].x * v[q].x + v[q].y * v[q].y) + (v[q].z * v[q].z + v[q].w * v[q].w); }
        const float rstd = 1.0f / sqrtf(wave_sum(s2) * (1.0f / DMODEL) + EPS);
        GAS f32x4* o = (GAS f32x4*)(A->out + (size_t)r * DMODEL) + F.lane;
#pragma unroll
        for (int q = 0; q < 4; ++q) o[64 * q] = v[q] * rstd * *(const f32x4*)(g + 4 * F.lane + 256 * q);
    }
}
__device__ __forceinline__ void attn_phase(const Frame& F, ArgsP A, int layer, bool do_ctx, char* lds) {
    const attn_body::bf16* QKV = (const attn_body::bf16*)(A->ws + WS_U); attn_body::bf16* O = (attn_body::bf16*)(A->ws + WS_O);
    const float* rpb = A->in[11] + (size_t)layer * 8 * 15 * 31;
#ifndef NO_MODE0
    {
        const int per = (512 + F.G - 1) / F.G, perc = do_ctx ? (128 + F.G - 1) / F.G : 0;
        for (int i = 0; i < per + perc; ++i) {
            int b, q0, qcol, kcol, vcol, ocol, tb, nt;
            if (i < per) { const int u = per * F.vcu + i; if (u >= 512) continue; const int qb = u & 7, hq = (u >> 3) & 7, kvh = hq >> 2; b = u >> 6; q0 = qb * 256; qcol = 1536 + hq * 64; kcol = 2048 + kvh * 64; vcol = 2176 + kvh * 64; ocol = 512 + hq * 64; tb = 0; nt = 36; }
            else { const int uc = perc * F.vcu + (i - per); if (uc >= 128) continue; const int v = uc & 63, h = v & 7; b = v >> 3; q0 = 2048; tb = 2048; nt = 4;
                if (uc < 64) { qcol = 1536 + h * 64; kcol = 2048 + (h >> 2) * 64; vcol = 2176 + (h >> 2) * 64; ocol = 512 + h * 64; }
                else { qcol = h * 64; kcol = 512 + h * 64; vcol = 1024 + h * 64; ocol = h * 64; } }
            attn_body::attn_unit<0, 8>(b, q0, qcol, kcol, vcol, ocol, tb, nt, 0, nullptr, QKV, O, lds);
        }
    }
#endif
#ifndef NO_MODE1
    for (int i = 0; i < (512 + F.G - 1) / F.G; ++i) {
        const int u = ((512 + F.G - 1) / F.G) * F.vcu + i; if (u >= 512) continue; const int qb = u & 7, h = (u >> 3) & 7, b = u >> 6;
        const int kr0 = min(max(4 * qb - 4, 0), 20);
        attn_body::attn_unit<1, 8>(b, qb * 256, h * 64, 512 + h * 64, 1024 + h * 64, h * 64, 0, 16, kr0, rpb + h * 15 * 31, QKV, O, lds);
    }
#endif
}

__global__ void __launch_bounds__(NWAVES * 64, 2) fwd_megakernel(Args A_unused_directly) {
    extern __shared__ __attribute__((aligned(16))) unsigned char lds[];
    cg::grid_group grid = cg::this_grid();
    Frame F;
    F.lds = (LAS unsigned char*)lds;
    F.refresh();
    F.G = gridDim.x; { const int bx = blockIdx.x; F.vcu = (F.G % 8 == 0) ? (bx % 8) * (F.G / 8) + bx / 8 : bx; }
    for (int u = F.tid; u < (LDS_BYTES - LDSCTL_OFF) / 4; u += NWAVES * 64) ((LAS unsigned*)(F.lds + LDSCTL_OFF))[u] = 0u;
    __syncthreads();
    XcdBarrier bar = xcd_barrier_post((unsigned*)(get_args()->ws + WS_CTL) + CW_BAR, (volatile LAS unsigned*)(F.lds + MISC_OFF) + 8);
#ifdef ALL_CG_SYNC
#define GRID_BAR() grid.sync()
#else
#define GRID_BAR() xcd_barrier(bar)
#endif

    p0_prologue(F, get_args());
#ifdef PROBE_P0X2
    __syncthreads(); p0_prologue(F, A);
#endif
    grid.sync();
    for (int l = 0; l < 2; ++l) {
        const bool last = (l == 1);
#define MODL(A_) ((const float*)((A_)->ws + WS_MODS) + (size_t)l * 9 * MODW)
#define WL(A_) ((A_)->ws + WS_W + (size_t)l * SZ_WLAYER)
        for (int f = 0; f < 2; ++f) {
            const bool lat = last && f == 1;
            { ArgsP A = get_args(); modnorm_phase(F, A, l == 0 && f == 0, lat, (l == 1 && f == 0) ? 1 : ((l == 0 && f == 1) ? 2 : 0)  , (f == 0 ? A->in[6] : A->in[17]) + l * DMODEL, MODL(A), f == 0 ? 0 : 6); }
#ifdef PROBE_NORMX2
            if (f == 1) { GRID_BAR(); ArgsP A = get_args(); modnorm_phase(F, A, false, lat, false, A->in[17] + l * DMODEL, MODL(A), 6); }
#endif
            GRID_BAR();
            {
                ArgsP A = get_args(); unsigned char* ws = A->ws; unsigned char* wl = WL(A);
                pg8::Gemm g{(const pg8::bf16_t*)A->out, (const pg8::bf16_t*)(wl + (f == 0 ? OFF_W13A : OFF_W13B)), MROWS, N13, DMODEL};
                pg8::Sched2 S; S.init(N13, DMODEL, F.G, (int)blockIdx.x, lat, false);
                pg8::EpiSwiglu E{(pg8::bf16_t*)(ws + WS_U), DFF};
#ifndef NO_G1
                pg8::gemm_phase<pg8::EpiSwiglu, pg8::Sched2, true, true>(F.lds, g, S, E);
#endif
#ifdef PROBE_G1X2
                GRID_BAR(); pg8::gemm_phase<pg8::EpiSwiglu, pg8::Sched2, true, true>(F.lds, g, S, E);
#endif
            }
            GRID_BAR();
            {
                ArgsP A = get_args(); unsigned char* ws = A->ws; unsigned char* wl = WL(A); const float* modl = MODL(A);
                pg8::Gemm g{(const pg8::bf16_t*)(ws + WS_U), (const pg8::bf16_t*)(wl + (f == 0 ? OFF_W2A : OFF_W2B)), MROWS, DMODEL, DFF};
                pg8::Sched2 S; S.init(DMODEL, DFF, F.G, (int)blockIdx.x, lat, true);
                pg8::EpiResid E{(float*)(ws + WS_XS), modl + (f == 0 ? 2 : 8) * DMODEL, 0.5f, ws, (unsigned char*)A->out, 0};
#ifndef NO_G2
                pg8::gemm_phase<pg8::EpiResid, pg8::Sched2, true, true>(F.lds, g, S, E);
#endif
#ifdef PROBE_G2X3
                if (!(l == 1 && f == 1)) { GRID_BAR(); E.s = -0.5f; S.cpu = 0; S.full = S.nwg; pg8::gemm_phase<pg8::EpiResid, pg8::Sched2, true, true>(F.lds, g, S, E);
                GRID_BAR(); E.s = 0.5f; pg8::gemm_phase<pg8::EpiResid, pg8::Sched2, true, true>(F.lds, g, S, E); }
#endif
            }
            GRID_BAR();
            if (f == 0) {
                { ArgsP A = get_args(); modnorm_phase(F, A, false, false, 1  , A->in[9] + l * DMODEL, MODL(A), 3); }
                GRID_BAR();
                {
                    ArgsP A = get_args(); unsigned char* ws = A->ws; unsigned char* wl = WL(A); const float* rc = (const float*)(ws + WS_ROPE); const float* rs = rc + 1024;
                    pg8::Gemm g{(const pg8::bf16_t*)A->out, (const pg8::bf16_t*)(wl + OFF_WIN), MROWS, NIN, DMODEL};
                    pg8::Sched2 S; S.init(NIN, DMODEL, F.G, (int)blockIdx.x, false, false);
                    pg8::EpiQkv E{(pg8::bf16_t*)(ws + WS_U), A->in[12] + l * 64, A->in[13] + l * 64, rc, rs, QC2, EPS};
#ifndef NO_GIN
                    pg8::gemm_phase<pg8::EpiQkv, pg8::Sched2, true, true>(F.lds, g, S, E);
#endif
#ifdef PROBE_GINX2
                    GRID_BAR(); pg8::gemm_phase<pg8::EpiQkv, pg8::Sched2, true, true>(F.lds, g, S, E);
#endif
                }
                GRID_BAR();
#ifndef NO_ATTN
                attn_phase(F, get_args(), l, !last, (char*)lds);
#endif
#ifdef PROBE_ATTNX2
                GRID_BAR(); attn_phase(F, get_args(), l, !last, (char*)lds);
#endif
                GRID_BAR();
                { ArgsP A = get_args(); onorm_phase(F, A, last, A->in[14] + l * 512, A->in[15] + l * 512); }
                GRID_BAR();
                {
                    ArgsP A = get_args(); unsigned char* ws = A->ws; unsigned char* wl = WL(A); const float* modl = MODL(A);
                    pg8::Gemm g{(const pg8::bf16_t*)(ws + WS_O), (const pg8::bf16_t*)(wl + OFF_WOUT), MROWS, DMODEL, DMODEL};
                    pg8::Sched2 S; S.init(DMODEL, DMODEL, F.G, (int)blockIdx.x, last, true);
                    pg8::EpiResid E{(float*)(ws + WS_XS), modl + 5 * DMODEL, 1.0f, ws, (unsigned char*)A->out, 1};
#ifndef NO_GOUT
                    pg8::gemm_phase<pg8::EpiResid, pg8::Sched2, true, true>(F.lds, g, S, E);
#endif
                }
                GRID_BAR();
            }
        }
    }
    final_phase(F, get_args());
}

extern "C" void kernel_launch(void* const* d_in, const int* in_sizes, int n_in, void* d_out, int out_size, void* d_ws, size_t ws_size, hipStream_t stream) {
    static int grid = 0;
    if (grid == 0) {
        if (n_in != 21 || out_size != NBATCH * SEQL * DMODEL || ws_size < WS_END + pg8::SLAB_BYTES) { fprintf(stderr, "kernel_launch: unexpected shapes (n_in %d, out %d, ws %zu, need %zu)\n", n_in, out_size, ws_size, (size_t)WS_END); grid = -1; return; }
        int dev = 0, cus = 0, per_cu = 0;
        if (hipGetDevice(&dev) != hipSuccess || hipDeviceGetAttribute(&cus, hipDeviceAttributeMultiprocessorCount, dev) != hipSuccess) { grid = -1; return; }
        if (hipFuncSetAttribute((const void*)fwd_megakernel, hipFuncAttributeMaxDynamicSharedMemorySize, LDS_BYTES) != hipSuccess) { fprintf(stderr, "kernel_launch: hipFuncSetAttribute failed\n"); grid = -1; return; }
        if (hipOccupancyMaxActiveBlocksPerMultiprocessor(&per_cu, (const void*)fwd_megakernel, NWAVES * 64, LDS_BYTES) != hipSuccess || per_cu < 1) { fprintf(stderr, "kernel_launch: occupancy query says %d blocks per CU\n", per_cu); (void)hipGetLastError(); grid = -1; return; }
        grid = cus;
    }
    if (grid < 0) return;
    (void)hipMemsetAsync((char*)d_ws + WS_CTL, 0, CTL_ZERO_BYTES, stream);
    Args a{};
    for (int i = 0; i < 21; ++i) a.in[i] = (const float*)d_in[i];
    a.out = (float*)d_out; a.ws = (unsigned char*)d_ws;
    void* args[] = {&a};
    hipError_t e = hipLaunchCooperativeKernel((const void*)fwd_megakernel, dim3(grid), dim3(NWAVES * 64), args, LDS_BYTES, stream);
    if (e != hipSuccess) fprintf(stderr, "kernel_launch: cooperative launch failed: %s (grid %d)\n", hipGetErrorString(e), grid);
}
```

```cpp
#include <hip/hip_runtime.h>
#include <hip/hip_bf16.h>
#include <hip/hip_cooperative_groups.h>
#include <cstdio>
#include <cstdint>
#include <cmath>
namespace cg = cooperative_groups;
#define WS_O_BYTES 265289728ull
#define WS_END_BYTES 303038464ull
#define WS_U_BYTES 161480704ull
namespace pg8 {
#define PG8_LAS __attribute__((address_space(3)))
typedef unsigned short bf16_t;
typedef short bf16x8 __attribute__((ext_vector_type(8)));
typedef float f32x4 __attribute__((ext_vector_type(4)));
typedef unsigned u32x4 __attribute__((ext_vector_type(4)));
constexpr int BM = 256, BK = 64, HALF = 128, HTB = HALF * BK * 2  , STAGE_BYTES = 8 * HTB, NXCD = 8, WGM = 8;

__host__ __device__ __forceinline__ int lds_byte(int r, int c) { const int st = (r >> 4) * 2 + (c >> 5), rr = r & 15, cc = c & 31, ob = rr * 64 + cc * 2; return st * 1024 + (ob ^ (((ob >> 9) & 1) << 5)); }
__host__ __device__ __forceinline__ void stage_rc(int b, int& R, int& C) { const int st = b / 1024, sb = b % 1024, swz = sb ^ (((sb >> 9) & 1) << 5); R = (st >> 1) * 16 + swz / 64; C = (st & 1) * 32 + (swz % 64) / 2; }
__host__ __device__ __forceinline__ int perm32(int rho) { const int n = rho >> 4, i = rho & 15; return 8 * (i >> 2) + 4 * n + (i & 3); }

struct Unit { int pm, pn, k0, nk, ch, part; };
struct Gemm { const bf16_t* A; const bf16_t* Bt; int M, N, K; };

struct StaticOrder {
    int nM, nN, nwg, G, c;
    __host__ __device__ void init(int M, int N, int G_, int c_) { nM = M / BM; nN = N / BM; nwg = nM * nN; G = G_; c = c_; }
    __host__ __device__ bool next(int i, Unit& u) const {
        const long L = (long)i * G + c; if (L >= nwg) return false;
        int wgid = (int)L; { const int q = nwg / NXCD, r = nwg % NXCD, xcd = wgid % NXCD, off = wgid / NXCD; wgid = (xcd < r ? xcd * (q + 1) : r * (q + 1) + (xcd - r) * q) + off; }
        const int nig = WGM * nN, gid = wgid / nig, fm = gid * WGM, gsz = (nM - fm) < WGM ? (nM - fm) : WGM;
        u.pm = fm + ((wgid % nig) % gsz); u.pn = (wgid % nig) / gsz; u.k0 = 0; u.nk = 0; u.ch = 0; u.part = 0; return true;
    }
    __device__ __forceinline__ void a_ready(const Unit&) const {}
    __device__ __forceinline__ void done(const Unit&) const {}
};

__device__ __forceinline__ unsigned cvt_pk_bf16(float lo, float hi) { unsigned r; asm volatile("v_cvt_pk_bf16_f32 %0, %1, %2" : "=v"(r) : "v"(lo), "v"(hi)); return r; }
typedef float f32x2 __attribute__((ext_vector_type(2)));
typedef unsigned u32x2 __attribute__((ext_vector_type(2)));
constexpr size_t SLAB_BYTES = (size_t)2048 * 1024 * 4, SLAB_WS_O = (size_t)WS_O_BYTES, SLAB_WS_END = (size_t)WS_END_BYTES, SLAB_OUT = (size_t)36 << 20;
__device__ __forceinline__ float* part_slab(unsigned char* ws, unsigned char* outb, int ch, int sel) {
    if (sel) return (float*)(ws + WS_U_BYTES + (size_t)ch * SLAB_BYTES);
    return (float*)(ch < 4 ? ws + SLAB_WS_O + (size_t)ch * SLAB_BYTES : (ch == 4 ? ws + SLAB_WS_END : outb + SLAB_OUT + (size_t)(ch - 5) * SLAB_BYTES));
}
struct EpiSwiglu {
    static constexpr bool PERM = true, AFTER_DRAIN = false;
    bf16_t* U; int ldu;
    __device__ __forceinline__ void operator()(const f32x4 (&acc)[2][2][4][2], const Unit& u, int wr, int wc, int fr, int fq) const {
        const int row0 = u.pm * BM + wr * 64 + fr, col0 = u.pn * HALF + wc * 32 + 8 * fq;
#pragma unroll
        for (int ai = 0; ai < 2; ++ai)
#pragma unroll
            for (int m = 0; m < 4; ++m) {
                float r[8];
#pragma unroll
                for (int n = 0; n < 2; ++n)
#pragma unroll
                    for (int e = 0; e < 4; ++e) { const float a = acc[ai][0][m][n][e], g = acc[ai][1][m][n][e];
                        r[n * 4 + e] = a * g * __builtin_amdgcn_rcpf(1.0f + __builtin_amdgcn_exp2f(-1.4426950408889634f * g)); }
                u32x4 w; w.x = cvt_pk_bf16(r[0], r[1]); w.y = cvt_pk_bf16(r[2], r[3]); w.z = cvt_pk_bf16(r[4], r[5]); w.w = cvt_pk_bf16(r[6], r[7]);
                *(u32x4*)(U + (size_t)(row0 + ai * HALF + m * 16) * ldu + col0) = w; }
    }
};
struct EpiResid {
    static constexpr bool PERM = false, AFTER_DRAIN = false;
    float* X; const float* gate; float s;
    unsigned char* ws; unsigned char* outb; int sel;
    __device__ __forceinline__ void operator()(const f32x4 (&acc)[2][2][4][2], const Unit& u, int wr, int wc, int fr, int fq) const {
        const int j = (u.pm % 9 == 8) ? 8 : u.pm / 9;
        const int row0 = u.pm * BM + wr * 64 + fr, col0 = u.pn * BM + wc * 32 + 4 * fq;
        const float* gp = gate + (size_t)j * 9216 + col0;
        float* slab = u.part ? part_slab(ws, outb, u.ch, sel) - (size_t)16384 * 1024 : X;
        f32x4 gv[2][2];
#pragma unroll
        for (int bj = 0; bj < 2; ++bj)
#pragma unroll
            for (int n = 0; n < 2; ++n) gv[bj][n] = *(const f32x4*)(gp + bj * HALF + n * 16) * s;
#pragma unroll
        for (int ai = 0; ai < 2; ++ai)
#pragma unroll
            for (int m = 0; m < 4; ++m) { float* rowp = X + (size_t)(row0 + ai * HALF + m * 16) * 1024 + col0;
#pragma unroll
                for (int bj = 0; bj < 2; ++bj)
#pragma unroll
                    for (int n = 0; n < 2; ++n) { float* pf = rowp + bj * HALF + n * 16; const f32x4 d = gv[bj][n] * acc[ai][bj][m][n];
                        if (u.part) *(f32x4*)(slab + (pf - X)) = d;
                        else { f32x4* p = (f32x4*)pf; *p = *p + d; } }
                if (m & 1) asm volatile("" ::: "memory"); }
    }
};
struct EpiQkv {
    static constexpr bool PERM = true, AFTER_DRAIN = false;
    bf16_t* QKV; const float* qn; const float* kn; const float* rc; const float* rs; float c2; float eps;
    __device__ __forceinline__ void operator()(const f32x4 (&acc)[2][2][4][2], const Unit& u, int wr, int wc, int fr, int fq) const {
        const int hh = u.pn * 4 + wc;
        const bool isq = (hh < 8) || (hh >= 24 && hh < 32), nrm = (hh >= 24 && hh < 34);
        const float* gn = (hh < 32) ? qn : kn;
        const int tq = u.pm % 9; const bool latent = tq != 8; const int tbase = tq * 256;
        f32x4 gv[2][2];
#pragma unroll
        for (int bj = 0; bj < 2; ++bj)
#pragma unroll
            for (int n = 0; n < 2; ++n) gv[bj][n] = nrm ? *(const f32x4*)(gn + 32 * bj + 16 * n + 4 * fq) : (f32x4){1.f, 1.f, 1.f, 1.f};
        const float osc = isq ? c2 : 1.0f;
#pragma unroll
        for (int ai = 0; ai < 2; ++ai)
#pragma unroll
            for (int m = 0; m < 4; ++m) {
                const int rit = ai * HALF + wr * 64 + m * 16 + fr; const size_t row = (size_t)u.pm * BM + rit;
                f32x4 v[2][2];
#pragma unroll
                for (int bj = 0; bj < 2; ++bj)
#pragma unroll
                    for (int n = 0; n < 2; ++n) v[bj][n] = acc[ai][bj][m][n];
                if (nrm) {
                    float ss = 0.f;
#pragma unroll
                    for (int bj = 0; bj < 2; ++bj)
#pragma unroll
                        for (int n = 0; n < 2; ++n) ss += (v[bj][n][0] * v[bj][n][0] + v[bj][n][1] * v[bj][n][1]) + (v[bj][n][2] * v[bj][n][2] + v[bj][n][3] * v[bj][n][3]);
                    ss += __shfl_xor(ss, 16); ss += __shfl_xor(ss, 32);
                    const float r = 1.0f / sqrtf(ss * (1.0f / 64.0f) + eps);
#pragma unroll
                    for (int bj = 0; bj < 2; ++bj)
#pragma unroll
                        for (int n = 0; n < 2; ++n) v[bj][n] = v[bj][n] * r * gv[bj][n];
                    if (latent) {
                        const int t = tbase + rit, pr = t >> 6, pc = t & 63;
#pragma unroll
                        for (int bj = 0; bj < 2; ++bj) { const int pos = bj ? pc : pr;
                            const f32x4 co = *(const f32x4*)(rc + pos * 16 + 4 * fq), si = *(const f32x4*)(rs + pos * 16 + 4 * fq);
                            const f32x4 x1 = v[bj][0], x2 = v[bj][1];
                            v[bj][0] = x1 * co - x2 * si; v[bj][1] = x2 * co + x1 * si; }
                    }
                }
                if (nrm) {
                    bf16_t* op = QKV + row * 2304 + hh * 64 + 4 * fq;
#pragma unroll
                    for (int bj = 0; bj < 2; ++bj)
#pragma unroll
                        for (int n = 0; n < 2; ++n) { const f32x4 o = v[bj][n] * osc; u32x2 w; w.x = cvt_pk_bf16(o[0], o[1]); w.y = cvt_pk_bf16(o[2], o[3]); *(u32x2*)(op + 32 * bj + 16 * n) = w; }
                } else {
                    bf16_t* op = QKV + row * 2304 + hh * 64 + 8 * fq;
#pragma unroll
                    for (int bj = 0; bj < 2; ++bj) { const f32x4 o0 = v[bj][0] * osc, o1 = v[bj][1] * osc; u32x4 w; w.x = cvt_pk_bf16(o0[0], o0[1]); w.y = cvt_pk_bf16(o0[2], o0[3]); w.z = cvt_pk_bf16(o1[0], o1[1]); w.w = cvt_pk_bf16(o1[2], o1[3]); *(u32x4*)(op + 32 * bj) = w; }
                }
                asm volatile("" ::: "memory");
            }
    }
};
struct Sched2 {
    int nM, nN, nwg, G, c, nt, full, cpu; bool skip;
    __device__ __forceinline__ void init(int N, int K, int G_, int c_, bool latent_only, bool split) {
        nM = latent_only ? 64 : 72; nN = N / BM; nwg = nM * nN; G = G_; c = c_; nt = K / BK; skip = latent_only; full = nwg; cpu = 0;
        if (split) { const int rem = nwg % G; if (rem == 32 && nwg == 288 && G == 256 && (nt / 2) >= G / rem)   { full = nwg - rem; cpu = G / rem; } }
    }
    __device__ __forceinline__ bool next(int i, Unit& u) const {
        const int L = i * G + c;
        int wgid, k0 = 0, nk = nt, ch = 0, part = 0;
        if (L < full) { wgid = L; const int q = full / NXCD, r = full % NXCD, xcd = wgid % NXCD, off = wgid / NXCD; wgid = (xcd < r ? xcd * (q + 1) : r * (q + 1) + (xcd - r) * q) + off; }
        else if (cpu && L < full + G) { const int j = L - full; ch = j % cpu; wgid = full + j / cpu;
            const int pairs = nt / 2, base = pairs / cpu, ext = pairs % cpu; k0 = 2 * (ch * base + (ch < ext ? ch : ext)); nk = 2 * (base + (ch < ext ? 1 : 0)); part = 1; }
        else return false;
        const int nig = WGM * nN, gid = wgid / nig, fm = gid * WGM, gsz = (nM - fm) < WGM ? (nM - fm) : WGM;
        int pm = fm + ((wgid % nig) % gsz); const int pn = (wgid % nig) / gsz;
        if (skip) pm += pm >> 3;
        u.pm = pm; u.pn = pn; u.k0 = k0; u.nk = nk; u.ch = ch; u.part = part;
        return true;
    }
    __device__ __forceinline__ void a_ready(const Unit&) const {}
    __device__ __forceinline__ void done(const Unit&) const {}
};
template <class Epi, class Sched, bool ALIGN_EPI = false, bool SP2 = false>
__device__ __forceinline__ void gemm_phase(PG8_LAS unsigned char* lds, const Gemm g, const Sched& S, const Epi& E) {
    int tid_ = threadIdx.x; asm volatile("" : "+v"(tid_));
    const int tid = tid_, wid = __builtin_amdgcn_readfirstlane(tid >> 6), lane = tid & 63, wr = wid >> 2, wc = wid & 3, fr = lane & 15, fq = lane >> 4;
    const int K = g.K;
    unsigned voffA[2], voffB[2];
#pragma unroll
    for (int i = 0; i < 2; ++i) { int R, C; stage_rc(tid * 16 + i * 8192, R, C); const int Rb = Epi::PERM ? ((R & ~31) + perm32(R & 31)) : R;
        voffA[i] = (unsigned)(R * K + C) * 2u; voffB[i] = (unsigned)(Rb * K + C) * 2u; }
    const size_t kstep = (size_t)(BK * 2);
    const size_t hstep = (size_t)HALF * K * 2;
    const size_t tstep = 2 * hstep;
    const unsigned ldsw = (unsigned)wid * 1024u;
    const int aoff = lds_byte(wr * 64 + fr, fq * 8), boff = lds_byte(wc * 32 + fr, fq * 8);
#define PG8_SA(b, h) (((b) * 2 + (h)) * HTB)
#define PG8_SB(b, h) ((4 + (b) * 2 + (h)) * HTB)
#define PG8_STAGE(bufoff, gbase, voff) do { _Pragma("unroll") for (int _i = 0; _i < 2; ++_i) \
        __builtin_amdgcn_global_load_lds((const unsigned*)((const char*)(gbase) + (voff)[_i]), (PG8_LAS unsigned*)(lds + (bufoff) + ldsw + _i * 8192), 16, 0, 0); } while (0)
#define PG8_LDA(dst, b, h) do { _Pragma("unroll") for (int m = 0; m < 4; ++m) _Pragma("unroll") for (int k = 0; k < 2; ++k) dst[m][k] = *(const PG8_LAS bf16x8*)(lds + PG8_SA(b, h) + aoff + m * 2048 + k * 1024); } while (0)
#define PG8_LDB(dst, b, h) do { _Pragma("unroll") for (int n = 0; n < 2; ++n) _Pragma("unroll") for (int k = 0; k < 2; ++k) dst[n][k] = *(const PG8_LAS bf16x8*)(lds + PG8_SB(b, h) + boff + n * 2048 + k * 1024); } while (0)
#define PG8_MMA(ai, bj, At, Bt) do { __builtin_amdgcn_s_setprio(1); _Pragma("unroll") for (int m = 0; m < 4; ++m) _Pragma("unroll") for (int n = 0; n < 2; ++n) _Pragma("unroll") for (int k = 0; k < 2; ++k) \
        acc[ai][bj][m][n] = __builtin_amdgcn_mfma_f32_16x16x32_bf16(Bt[n][k], At[m][k], acc[ai][bj][m][n], 0, 0, 0); __builtin_amdgcn_s_setprio(0); } while (0)
#define PG8_WAIT_V(n) asm volatile("s_waitcnt vmcnt(" #n ")" ::: "memory")
#define PG8_WAIT_L(n) asm volatile("s_waitcnt lgkmcnt(" #n ")" ::: "memory")
#define PG8_BAR __builtin_amdgcn_s_barrier()
#define PG8_SCHED __builtin_amdgcn_sched_barrier(0)
    Unit cur, nxt; int ui = 0;
    if (!S.next(0, cur)) return;
    f32x4 acc[2][2][4][2];
#pragma unroll
    for (int a = 0; a < 2; ++a)
#pragma unroll
        for (int b = 0; b < 2; ++b)
#pragma unroll
            for (int m = 0; m < 4; ++m)
#pragma unroll
                for (int n = 0; n < 2; ++n) acc[a][b][m][n] = (f32x4){0.f, 0.f, 0.f, 0.f};
    bf16x8 At[4][2], B0[2][2], B1[2][2];
    const char* cA = (const char*)g.A + (size_t)cur.pm * tstep + (size_t)cur.k0 * kstep; const char* cB = (const char*)g.Bt + (size_t)cur.pn * tstep + (size_t)cur.k0 * kstep;
    S.a_ready(cur);
    if constexpr (SP2) {
        PG8_STAGE(PG8_SB(0, 0), cB, voffB); PG8_STAGE(PG8_SB(0, 1), cB + hstep, voffB); PG8_STAGE(PG8_SA(0, 0), cA, voffA); PG8_STAGE(PG8_SA(0, 1), cA + hstep, voffA);
        if (wr == 1) PG8_BAR;
        PG8_WAIT_V(2); PG8_BAR;
        PG8_STAGE(PG8_SB(1, 0), cB + kstep, voffB); PG8_STAGE(PG8_SA(1, 0), cA + kstep, voffA); PG8_STAGE(PG8_SB(1, 1), cB + hstep + kstep, voffB);
        PG8_WAIT_V(6); PG8_BAR;
    } else {
        PG8_STAGE(PG8_SB(0, 0), cB, voffB); PG8_STAGE(PG8_SA(0, 0), cA, voffA); PG8_STAGE(PG8_SB(0, 1), cB + hstep, voffB); PG8_STAGE(PG8_SA(0, 1), cA + hstep, voffA);
        if (wr == 1) PG8_BAR;
        PG8_WAIT_V(4); PG8_BAR;
        PG8_STAGE(PG8_SB(1, 0), cB + kstep, voffB); PG8_STAGE(PG8_SA(1, 0), cA + kstep, voffA); PG8_STAGE(PG8_SB(1, 1), cB + hstep + kstep, voffB);
        PG8_WAIT_V(6); PG8_BAR;
    }
    for (;;) {
        const bool has_next = S.next(ui + 1, nxt);
        const char* nA = has_next ? (const char*)g.A + (size_t)nxt.pm * tstep + (size_t)nxt.k0 * kstep : cA; const char* nB = has_next ? (const char*)g.Bt + (size_t)nxt.pn * tstep + (size_t)nxt.k0 * kstep : cB;
        const int nt = cur.nk;
        for (int t = 0; t < nt; t += 2) {
            const bool last = (t == nt - 2);
            const char* a1 = cA + (size_t)(t + 1) * kstep;
            const char* a2 = last ? nA : cA + (size_t)(t + 2) * kstep; const char* b2 = last ? nB : cB + (size_t)(t + 2) * kstep;
            const char* a3 = a2 + kstep; const char* b3 = b2 + kstep;
            if (last && has_next) S.a_ready(nxt);
            if constexpr (SP2) {
            PG8_LDB(B0, 0, 0); PG8_LDB(B1, 0, 1); PG8_SCHED; PG8_LDA(At, 0, 0); PG8_STAGE(PG8_SA(1, 1), a1 + hstep, voffA);
            PG8_WAIT_V(8); PG8_WAIT_L(0); PG8_BAR; PG8_MMA(0, 0, At, B0); PG8_MMA(0, 1, At, B1); PG8_BAR; PG8_SCHED;
            PG8_LDA(At, 0, 1); PG8_STAGE(PG8_SB(0, 0), b2, voffB); PG8_STAGE(PG8_SB(0, 1), b2 + hstep, voffB); PG8_STAGE(PG8_SA(0, 0), a2, voffA);
            PG8_WAIT_V(8); PG8_WAIT_L(0); PG8_BAR; PG8_MMA(1, 0, At, B0); PG8_MMA(1, 1, At, B1); PG8_BAR; PG8_SCHED;
            PG8_LDB(B0, 1, 0); PG8_LDB(B1, 1, 1); PG8_SCHED; PG8_LDA(At, 1, 0); PG8_STAGE(PG8_SA(0, 1), a2 + hstep, voffA);
            PG8_WAIT_V(8); PG8_WAIT_L(0); PG8_BAR; PG8_MMA(0, 0, At, B0); PG8_MMA(0, 1, At, B1); PG8_BAR; PG8_SCHED;
            PG8_LDA(At, 1, 1); PG8_STAGE(PG8_SB(1, 0), b3, voffB); PG8_STAGE(PG8_SB(1, 1), b3 + hstep, voffB); PG8_STAGE(PG8_SA(1, 0), a3, voffA);
            PG8_WAIT_V(8); PG8_WAIT_L(0); PG8_BAR; PG8_MMA(1, 0, At, B0); PG8_MMA(1, 1, At, B1); PG8_BAR; PG8_SCHED;
            } else {
            PG8_LDB(B0, 0, 0); PG8_SCHED; PG8_LDA(At, 0, 0); PG8_STAGE(PG8_SA(1, 1), a1 + hstep, voffA);
            PG8_WAIT_L(8); PG8_BAR; PG8_WAIT_L(0); PG8_MMA(0, 0, At, B0); PG8_BAR; PG8_SCHED;
            PG8_LDB(B1, 0, 1); PG8_STAGE(PG8_SB(0, 0), b2, voffB);
            PG8_BAR; PG8_WAIT_L(0); PG8_MMA(0, 1, At, B1); PG8_BAR;
            PG8_LDA(At, 0, 1); PG8_STAGE(PG8_SA(0, 0), a2, voffA);
            PG8_BAR; PG8_WAIT_L(0); PG8_MMA(1, 0, At, B0); PG8_BAR; PG8_SCHED;
            PG8_STAGE(PG8_SB(0, 1), b2 + hstep, voffB);
            PG8_WAIT_V(6); PG8_BAR; PG8_MMA(1, 1, At, B1); PG8_BAR;
            PG8_LDB(B0, 1, 0); PG8_SCHED; PG8_LDA(At, 1, 0); PG8_STAGE(PG8_SA(0, 1), a2 + hstep, voffA);
            PG8_WAIT_L(8); PG8_BAR; PG8_WAIT_L(0); PG8_MMA(0, 0, At, B0); PG8_BAR; PG8_SCHED;
            PG8_LDB(B1, 1, 1); PG8_STAGE(PG8_SB(1, 0), b3, voffB);
            PG8_BAR; PG8_WAIT_L(0); PG8_MMA(0, 1, At, B1); PG8_BAR;
            PG8_LDA(At, 1, 1); PG8_STAGE(PG8_SA(1, 0), a3, voffA);
            PG8_BAR; PG8_WAIT_L(0); PG8_MMA(1, 0, At, B0); PG8_BAR; PG8_SCHED;
            PG8_STAGE(PG8_SB(1, 1), b3 + hstep, voffB);
            PG8_WAIT_V(6); PG8_BAR; PG8_MMA(1, 1, At, B1); PG8_BAR;
            }
        }
        if constexpr (ALIGN_EPI) { if (wr == 0) PG8_BAR; }
        if constexpr (!Epi::AFTER_DRAIN) { E(acc, cur, wr, wc, fr, fq); S.done(cur); }
        if (!has_next) break;
#pragma unroll
        for (int a = 0; a < 2; ++a)
#pragma unroll
            for (int b = 0; b < 2; ++b)
#pragma unroll
                for (int m = 0; m < 4; ++m)
#pragma unroll
                    for (int n = 0; n < 2; ++n) acc[a][b][m][n] = (f32x4){0.f, 0.f, 0.f, 0.f};
        cur = nxt; cA = nA; cB = nB; ++ui;
        if constexpr (ALIGN_EPI) { if (wr == 1) PG8_BAR; }
    }
    PG8_WAIT_V(0);
    if constexpr (!ALIGN_EPI) { if (wr == 0) PG8_BAR; }
    PG8_BAR;
    if constexpr (Epi::AFTER_DRAIN) { E.fused(acc, cur, wr, wc, fr, fq, lds, wid, lane); S.done(cur); }
#undef PG8_SA
#undef PG8_SB
#undef PG8_STAGE
#undef PG8_LDA
#undef PG8_LDB
#undef PG8_MMA
#undef PG8_WAIT_V
#undef PG8_WAIT_L
#undef PG8_BAR
#undef PG8_SCHED
}
}
namespace attn_body {
using bf16=__hip_bfloat16;
using bf16x8=__attribute__((ext_vector_type(8)))short;
using s16x4=__attribute__((ext_vector_type(4)))short;
using f32x16=__attribute__((ext_vector_type(16)))float;
using u32x4=__attribute__((ext_vector_type(4)))unsigned;
constexpr int D=64,PITCH=2304,OPITCH=1024,RPBATCH=2304;
constexpr int NW=8,QBLK=32,QB=QBLK*NW,KVBLK=64;
constexpr int ATTN_UNIT_ROWS=QB;
__device__ __forceinline__ int crow(int r,int hi){return (r&3)+8*(r>>2)+4*hi;}
#define SBAR() __builtin_amdgcn_sched_barrier(0)
__device__ __forceinline__ void cmask(f32x16&p0,f32x16&p1,int jb,int qrel,int hi){
  const float NEG=-INFINITY; int kb=64*jb+4*hi;
  #pragma unroll
  for(int r=0;r<16;++r){int kv=kb+(r&3)+8*(r>>2); if(kv>qrel)p0[r]=NEG; if(kv+32>qrel)p1[r]=NEG;}
}

template<int CK> __device__ __forceinline__ float sel_ck(float val,int c0,float neg){ int tmp; asm volatile("v_add_u32_e32 %1, %3, %2\n\tv_cmp_gt_u32_e32 vcc, 16, %1\n\tv_cndmask_b32_e32 %0, %4, %0, vcc":"+v"(val),"=&v"(tmp):"v"(c0),"n"(CK),"v"(neg):"vcc"); return val;}
__device__ __forceinline__ void na_mask(f32x16&p0,f32x16&p1,int t,int kr0,int rq,int rs,int cq,int cs,int hi,int h,const float*tab){
  if(t<4)return;
  const float NEG=-INFINITY; const int kr=kr0+t-4;
  if(kr<rs||kr>=rs+8){
    #pragma unroll
    for(int r=0;r<16;++r){p0[r]=NEG;p1[r]=NEG;}
    return; }
  const float*brow=tab+(kr-rq+7)*32+15-cq+4*hi; const int c0=4*hi-cs;
  #define CKOF(r) (((r)&3)+8*((r)>>2))
  #define NA1(r) do{ const float b0=brow[CKOF(r)], b1=brow[CKOF(r)+32]; p0[r]=sel_ck<CKOF(r)>(p0[r]+b0,c0,NEG); p1[r]=sel_ck<CKOF(r)+32>(p1[r]+b1,c0,NEG); }while(0)
  NA1(0);NA1(1);NA1(2);NA1(3); asm volatile("":::"memory");
  NA1(4);NA1(5);NA1(6);NA1(7); asm volatile("":::"memory");
  NA1(8);NA1(9);NA1(10);NA1(11); asm volatile("":::"memory");
  NA1(12);NA1(13);NA1(14);NA1(15);
  #undef NA1
  #undef CKOF
}
constexpr int NSLOT=3, SLOTB=8192;
constexpr int LDS_K=0, LDS_V=NSLOT*SLOTB, LDS_WS=2*NSLOT*SLOTB, LDS_OST=LDS_WS+NW*64*4, LDS_BYTES=LDS_OST+NW*4096;
constexpr float C2=0.125f*1.4426950408889634f;
__device__ __forceinline__ void glds16(const void*gsrc,unsigned lds_dst){unsigned keep;
  asm volatile("s_mov_b32 %0, m0\n\ts_mov_b32 m0, %2\n\ts_nop 0\n\tglobal_load_lds_dwordx4 %1, off\n\ts_mov_b32 m0, %0":"=&s"(keep):"v"(gsrc),"s"(lds_dst):"memory");}
__device__ __forceinline__ void glds16s(const void*sbase,unsigned voff,unsigned lds_dst){unsigned keep;
  asm volatile("s_mov_b32 %0, m0\n\ts_mov_b32 m0, %3\n\ts_nop 0\n\tglobal_load_lds_dwordx4 %1, %2\n\ts_mov_b32 m0, %0":"=&s"(keep):"v"(voff),"s"(sbase),"s"(lds_dst):"memory");}
__device__ __forceinline__ float max3f(float a,float b,float c){float r;asm("v_max3_f32 %0, %1, %2, %3":"=v"(r):"v"(a),"v"(b),"v"(c));return r;}
__device__ __forceinline__ float max2f(float a,float b){float r;asm("v_max_f32_e32 %0, %1, %2":"=v"(r):"v"(a),"v"(b));return r;}
__device__ __forceinline__ float fadd_s(float a,float b){float r;asm("v_add_f32_e32 %0, %1, %2":"=v"(r):"v"(a),"v"(b));return r;}
__device__ __forceinline__ float fsub_s(float a,float b){float r;asm("v_sub_f32_e32 %0, %1, %2":"=v"(r):"v"(a),"v"(b));return r;}
typedef float f32x2_t __attribute__((ext_vector_type(2))); typedef __bf16 bf16x2_t __attribute__((ext_vector_type(2)));
__device__ __forceinline__ unsigned cvtpk_s(float lo,float hi){f32x2_t v={lo,hi};bf16x2_t b=__builtin_convertvector(v,bf16x2_t);return __builtin_bit_cast(unsigned,b);}
#define WAIT_BAR(N) asm volatile("s_waitcnt vmcnt(" #N ") lgkmcnt(0)\n\ts_barrier":::"memory")

__device__ __forceinline__ void qkt(f32x16&p0,f32x16&p1,const char*Kslot,const bf16x8*qr,const f32x16&negm,int r32,int hi){
  const char*kb=Kslot+hi*1024+r32*16;
  #pragma unroll
  for(int d0=0;d0<4;++d0){
    const bf16x8 b0=*reinterpret_cast<const bf16x8*>(kb+d0*2048);
    const bf16x8 b1=*reinterpret_cast<const bf16x8*>(kb+d0*2048+512);
    if(d0==0){p0=__builtin_amdgcn_mfma_f32_32x32x16_bf16(b0,qr[0],negm,0,0,0);p1=__builtin_amdgcn_mfma_f32_32x32x16_bf16(b1,qr[0],negm,0,0,0);}
    else{p0=__builtin_amdgcn_mfma_f32_32x32x16_bf16(b0,qr[d0],p0,0,0,0);p1=__builtin_amdgcn_mfma_f32_32x32x16_bf16(b1,qr[d0],p1,0,0,0);}}
}
typedef __attribute__((address_space(3))) const char* lds_cptr;
typedef short v4i16_t __attribute__((ext_vector_type(4)));
__device__ __forceinline__ void kload8(bf16x8*kf,lds_cptr kp){
  kf[0]=*(const __attribute__((address_space(3))) bf16x8*)(kp);      kf[1]=*(const __attribute__((address_space(3))) bf16x8*)(kp+512);
  kf[2]=*(const __attribute__((address_space(3))) bf16x8*)(kp+2048); kf[3]=*(const __attribute__((address_space(3))) bf16x8*)(kp+2560);
  kf[4]=*(const __attribute__((address_space(3))) bf16x8*)(kp+4096); kf[5]=*(const __attribute__((address_space(3))) bf16x8*)(kp+4608);
  kf[6]=*(const __attribute__((address_space(3))) bf16x8*)(kp+6144); kf[7]=*(const __attribute__((address_space(3))) bf16x8*)(kp+6656);
}
__device__ __forceinline__ void kload2(bf16x8*kf,lds_cptr kp,int j){ kf[2*j]=*(const __attribute__((address_space(3))) bf16x8*)(kp+j*2048); kf[2*j+1]=*(const __attribute__((address_space(3))) bf16x8*)(kp+j*2048+512); }
__device__ __forceinline__ s16x4 vtr(lds_cptr p){ return __builtin_bit_cast(s16x4,__builtin_amdgcn_ds_read_tr16_b64_v4i16((__attribute__((address_space(3))) v4i16_t*)p)); }
__device__ __forceinline__ float rowmax(const f32x16&p0,const f32x16&p1){
  float a=max3f(p0[0],p0[1],p1[0]),b=max3f(p0[2],p0[3],p1[1]);a=max3f(a,p1[2],p1[3]);
  #pragma unroll
  for(int r=4;r<16;r+=4){a=max3f(a,p0[r],p0[r+1]);b=max3f(b,p0[r+2],p0[r+3]);a=max3f(a,p1[r],p1[r+1]);b=max3f(b,p1[r+2],p1[r+3]);}
  const float m=max2f(a,b);
  auto rr=__builtin_amdgcn_permlane32_swap(__float_as_uint(m),__float_as_uint(m),false,false);
  return max2f(__uint_as_float(rr[0]),__uint_as_float(rr[1]));
}
__device__ __forceinline__ void pv(f32x16*o,int vb,bf16x8 pa0,bf16x8 pa1,bf16x8 pa2,bf16x8 pa3){
  #pragma unroll
  for(int d0=0;d0<2;++d0){s16x4 lo[4],hi[4];
    #pragma unroll
    for(int ks=0;ks<4;++ks){
      asm volatile("ds_read_b64_tr_b16 %0,%1 offset:%c2":"=&v"(lo[ks]):"v"(vb),"i"(d0*4096+ks*1024):"memory");
      asm volatile("ds_read_b64_tr_b16 %0,%1 offset:%c2":"=&v"(hi[ks]):"v"(vb),"i"(d0*4096+ks*1024+512):"memory");}
    asm volatile("s_waitcnt lgkmcnt(0)":::"memory");SBAR();
    #define PK(k) (bf16x8){lo[k][0],lo[k][1],lo[k][2],lo[k][3],hi[k][0],hi[k][1],hi[k][2],hi[k][3]}
    o[d0]=__builtin_amdgcn_mfma_f32_32x32x16_bf16(pa0,PK(0),o[d0],0,0,0);
    o[d0]=__builtin_amdgcn_mfma_f32_32x32x16_bf16(pa1,PK(1),o[d0],0,0,0);
    o[d0]=__builtin_amdgcn_mfma_f32_32x32x16_bf16(pa2,PK(2),o[d0],0,0,0);
    o[d0]=__builtin_amdgcn_mfma_f32_32x32x16_bf16(pa3,PK(3),o[d0],0,0,0);
    #undef PK
  }
}

#ifndef ATTN_STORE16
#define ATTN_STORE16(p,v) (*(u32x4*)(p)=(v))
#endif
template<int MODE,int THRL> __device__ __forceinline__ void attn_unit(int b,int q0,int qcol,int kcol,int vcol,int ocol,int tb,int NTin,int kr0,const float*rpbh,const bf16*QKV,bf16*O,char*shm){
  int tid_=threadIdx.x; asm volatile("":"+v"(tid_)); const int tid=tid_,lane=tid&63,r32=lane&31,hi=lane>>5; const int wid=__builtin_amdgcn_readfirstlane(tid>>6);
  const long rowbase=(long)b*RPBATCH;
  const bf16*Qw=QKV+(rowbase+q0+wid*QBLK)*PITCH+qcol;
  const bf16*Kh=QKV+rowbase*PITCH+kcol,*Vh=QKV+rowbase*PITCH+vcol;
  const unsigned lds0=(unsigned)(uintptr_t)shm;
  float*wsf=(float*)(shm+LDS_WS)+wid*64;
  const unsigned koff=(unsigned)(lane*PITCH+wid*8)*2u;
  const unsigned voffv=(unsigned)((16*(wid&3)+(lane>>2))*PITCH+(wid>>2)*32+(lane&3)*8)*2u;
  const unsigned kdst=lds0+LDS_K+wid*1024, vdst=lds0+LDS_V+wid*1024;
  #define TROW(t) ((MODE==1)?(((t)<4)?(2048+64*(t)):(64*(kr0+(t)-4))):(tb+64*(t)))
  #define DMA_K(t,slot) glds16s(Kh+(long)TROW(t)*PITCH,koff,(unsigned)__builtin_amdgcn_readfirstlane(kdst+(slot)))
  #define DMA_V(t,slot) glds16s(Vh+(long)TROW(t)*PITCH,voffv,(unsigned)__builtin_amdgcn_readfirstlane(vdst+(slot)))
  const int vb0=(int)(lds0+LDS_V)+((lane>>4)&1)*32+(lane&3)*8+(4*hi+((lane&15)>>2))*64;
  const char*Kbase=shm+LDS_K; bf16x8 kf[8];
  const lds_cptr shm3=(lds_cptr)shm; const lds_cptr kp0=shm3+LDS_K+hi*1024+r32*16; const lds_cptr vp0=shm3+LDS_V+((lane>>4)&1)*32+(lane&3)*8+(4*hi+((lane&15)>>2))*64;
  const int NT=(MODE==1)?16:NTin;
  const int rq=(q0>>6)+(wid>>1), cq=(wid&1)*32+r32; const int rs=min(max(rq-4,0),24), cs=min(max(cq-8,0),48);
  float*tab=(float*)(shm+LDS_BYTES);
  if(MODE==1){ for(int i=tid;i<15*32;i+=NW*64){const int ii=i>>5,jj=i&31; tab[i]=(jj<31)?rpbh[ii*31+jj]*1.4426950408889634f:0.f;} }
  DMA_K(0,0);DMA_V(0,0);DMA_K(1,SLOTB);
  bf16x8 qr[4];
  #pragma unroll
  for(int d0=0;d0<4;++d0)qr[d0]=*reinterpret_cast<const bf16x8*>(&Qw[(long)r32*PITCH+d0*16+hi*8]);
  float mhat=0.f,l_reg=0.f;f32x16 o[2];o[0]=f32x16{};o[1]=f32x16{};const f32x16 negm=f32x16{};
  const int qrel=wid*QBLK+r32;
  #define CMASK(P0,P1,t) do{ if(MODE==1) na_mask(P0,P1,(t),kr0,rq,rs,cq,cs,hi,wid&1,tab); }while(0)
  bool resc=false;
  #define START(P0,P1) do{ const float rm=rowmax(P0,P1); resc=false; \
    { const float dl=rm; mhat=fadd_s(mhat,dl); \
      _Pragma("unroll") for(int r=0;r<16;++r){P0[r]=fsub_s(P0[r],dl);P1[r]=fsub_s(P1[r],dl);} \
      } \
    _Pragma("unroll") for(int r=0;r<16;++r)P0[r]=__builtin_amdgcn_exp2f(P0[r]); }while(0)
  #define RESC() do{ if(resc){ asm volatile("s_waitcnt lgkmcnt(0)":::"memory"); \
      _Pragma("unroll") for(int d_=0;d_<2;++d_) _Pragma("unroll") for(int r=0;r<16;++r)o[d_][r]*=wsf[crow(r,hi)]; } }while(0)
  f32x16 pA0,pA1,pB0,pB1;
  int sl_prev=0,sl_cur=0,sl_next=SLOTB;
  #define ROT() do{sl_prev=sl_cur;sl_cur=sl_next;sl_next=(sl_next==(NSLOT-1)*SLOTB)?0:sl_next+SLOTB;}while(0)
  DMA_K(2,2*SLOTB);
  WAIT_BAR(3);
  qkt(pA0,pA1,Kbase,qr,negm,r32,hi);asm volatile("s_nop 15\n\ts_nop 7":"+v"(pA0),"+v"(pA1));CMASK(pA0,pA1,0);
  START(pA0,pA1);
  _Pragma("unroll") for(int r=0;r<16;++r)pA1[r]=__builtin_amdgcn_exp2f(pA1[r]);
  WAIT_BAR(0);
  DMA_K(3,0);DMA_V(1,SLOTB);
  ROT();
  kload8(kf,kp0+sl_cur);
  WAIT_BAR(2);
  s16x4 vlo[8],vhi[8]; u32x4 pw0,pw1,pw2,pw3;
  #define PKW(P,B) cvtpk_s(P[B],P[B+1])
  #define PAF(k) __builtin_bit_cast(bf16x8,pw##k)
  #define VFR(i) (bf16x8){vlo[i][0],vlo[i][1],vlo[i][2],vlo[i][3],vhi[i][0],vhi[i][1],vhi[i][2],vhi[i][3]}
  #define PIN(x) asm volatile("":"+v"(x))
  #define MX3(a,b,c) __builtin_fmaxf(__builtin_fmaxf((a),(b)),(c))
  #define GAPA(MF,A0,A1,A2,A3,W0,W1,PW) do{ MF; sacc+=A0; sacc+=A1; sacc+=A2; sacc+=A3; PIN(sacc); W0; W1; PIN(PW); SBAR(); }while(0)
  #define EX(v) __builtin_amdgcn_exp2f(v)
  #define GAPB(MF,X,B) do{ MF; X[B]=EX(X[B]); X[B+1]=EX(X[B+1]); X[B+2]=EX(X[B+2]); X[B+3]=EX(X[B+3]); PIN(X); SBAR(); }while(0)
  #define VRD(i) do{ vlo[i]=vtr(vp_+(((i)>>2)*4096+((i)&3)*1024)); vhi[i]=vtr(vp_+(((i)>>2)*4096+((i)&3)*1024+512)); }while(0)
  #define KRD(G,j) do{ if(G){ kload2(kf,kp0+sl_next,j); SBAR(); } }while(0)
  #define STEP(C0,C1,P0,P1,t,GK,GV,GL) do{ SBAR(); \
    const lds_cptr vp_=vp0+sl_prev; \
    VRD(0); SBAR(); float sacc=(P0[0]+P0[1]); \
    GAPA(C0=__builtin_amdgcn_mfma_f32_32x32x16_bf16(kf[0],qr[0],negm,0,0,0), P0[2],P0[3],P0[4],P0[5],     pw0[0]=PKW(P0,0), pw0[1]=PKW(P0,2), pw0); \
    VRD(4); SBAR(); GAPA(C1=__builtin_amdgcn_mfma_f32_32x32x16_bf16(kf[1],qr[0],negm,0,0,0), P0[6],P0[7],P0[8],P0[9],     pw0[2]=PKW(P0,4), pw0[3]=PKW(P0,6), pw0); \
    VRD(1); SBAR(); GAPA(C0=__builtin_amdgcn_mfma_f32_32x32x16_bf16(kf[2],qr[1],C0,0,0,0),   P0[10],P0[11],P0[12],P0[13], pw1[0]=PKW(P0,8), pw1[1]=PKW(P0,10), pw1); \
    VRD(5); SBAR(); GAPA(C1=__builtin_amdgcn_mfma_f32_32x32x16_bf16(kf[3],qr[1],C1,0,0,0),   P0[14],P0[15],P1[0],P1[1],   pw1[2]=PKW(P0,12),pw1[3]=PKW(P0,14), pw1); \
    VRD(2); SBAR(); GAPA(C0=__builtin_amdgcn_mfma_f32_32x32x16_bf16(kf[4],qr[2],C0,0,0,0),   P1[2],P1[3],P1[4],P1[5],     pw2[0]=PKW(P1,0), pw2[1]=PKW(P1,2), pw2); \
    VRD(6); SBAR(); GAPA(C1=__builtin_amdgcn_mfma_f32_32x32x16_bf16(kf[5],qr[2],C1,0,0,0),   P1[6],P1[7],P1[8],P1[9],     pw2[2]=PKW(P1,4), pw2[3]=PKW(P1,6), pw2); \
    VRD(3); SBAR(); GAPA(C0=__builtin_amdgcn_mfma_f32_32x32x16_bf16(kf[6],qr[3],C0,0,0,0),   P1[10],P1[11],P1[12],P1[13], pw3[0]=PKW(P1,8), pw3[1]=PKW(P1,10), pw3); \
    VRD(7); SBAR(); GAPA(C1=__builtin_amdgcn_mfma_f32_32x32x16_bf16(kf[7],qr[3],C1,0,0,0),   P1[14],P1[15],0.f,0.f,       pw3[2]=PKW(P1,12),pw3[3]=PKW(P1,14), pw3); \
    l_reg+=sacc; \
    if(GK){DMA_K((t)+3,sl_cur);} if(GV){DMA_V((t)+1,sl_next);} \
    _Pragma("unroll") for(int r=0;r<16;++r){C0[r]-=mhat;C1[r]-=mhat;} \
    CMASK(C0,C1,t); \
    { float a=MX3(C0[0],C0[1],C1[0]),b=MX3(C0[2],C0[3],C1[1]); a=MX3(a,C1[2],C1[3]); \
      _Pragma("unroll") for(int r=4;r<16;r+=4){a=MX3(a,C0[r],C0[r+1]);b=MX3(b,C0[r+2],C0[r+3]);a=MX3(a,C1[r],C1[r+1]);b=MX3(b,C1[r+2],C1[r+3]);} \
      float rm=__builtin_fmaxf(a,b); { auto rr=__builtin_amdgcn_permlane32_swap(__float_as_uint(rm),__float_as_uint(rm),false,false); rm=__builtin_fmaxf(__uint_as_float(rr[0]),__uint_as_float(rr[1])); } \
      resc=false; \
      if(__builtin_expect(__any(rm>(float)THRL),0)){ const float dl=__builtin_fmaxf(rm,0.f); mhat+=dl; \
        _Pragma("unroll") for(int r=0;r<16;++r){C0[r]-=dl;C1[r]-=dl;} \
        const float f=__builtin_amdgcn_exp2f(-dl); l_reg*=f; if(hi==0)wsf[r32]=f; resc=true; } } \
    SBAR(); \
    GAPB(o[0]=__builtin_amdgcn_mfma_f32_32x32x16_bf16(PAF(0),VFR(0),o[0],0,0,0), C0,0); \
    GAPB(o[1]=__builtin_amdgcn_mfma_f32_32x32x16_bf16(PAF(0),VFR(4),o[1],0,0,0), C0,4); \
    KRD(GL,0); GAPB(o[0]=__builtin_amdgcn_mfma_f32_32x32x16_bf16(PAF(1),VFR(1),o[0],0,0,0), C0,8); \
    KRD(GL,1); GAPB(o[1]=__builtin_amdgcn_mfma_f32_32x32x16_bf16(PAF(1),VFR(5),o[1],0,0,0), C0,12); \
    KRD(GL,2); GAPB(o[0]=__builtin_amdgcn_mfma_f32_32x32x16_bf16(PAF(2),VFR(2),o[0],0,0,0), C1,0); \
    KRD(GL,3); GAPB(o[1]=__builtin_amdgcn_mfma_f32_32x32x16_bf16(PAF(2),VFR(6),o[1],0,0,0), C1,4); \
    GAPB(o[0]=__builtin_amdgcn_mfma_f32_32x32x16_bf16(PAF(3),VFR(3),o[0],0,0,0), C1,8); \
    GAPB(o[1]=__builtin_amdgcn_mfma_f32_32x32x16_bf16(PAF(3),VFR(7),o[1],0,0,0), C1,12); \
    }while(0)
  int t=1;
  _Pragma("nounroll") for(;t+5<NT;t+=2){
    STEP(pB0,pB1,pA0,pA1,t,true,true,true);     WAIT_BAR(2); RESC(); ROT();
    STEP(pA0,pA1,pB0,pB1,t+1,true,true,true);   WAIT_BAR(2); RESC(); ROT();
  }
  #define ENDW(tt) do{ if((tt)+3<NT){WAIT_BAR(2);} else if((tt)+2<NT){WAIT_BAR(1);} else {WAIT_BAR(0);} }while(0)
  _Pragma("nounroll") for(;t+1<NT;t+=2){
    STEP(pB0,pB1,pA0,pA1,t,(t+3<NT),(t+1<NT),(t+1<NT));       ENDW(t);   RESC(); ROT();
    STEP(pA0,pA1,pB0,pB1,t+1,(t+4<NT),(t+2<NT),(t+2<NT));     ENDW(t+1); RESC(); ROT();
  }
  STEP(pB0,pB1,pA0,pA1,NT-1,false,false,false); RESC();
  { float sacc=pB0[0]+pB0[1]; _Pragma("unroll") for(int r=2;r<16;++r)sacc+=pB0[r]; _Pragma("unroll") for(int r=0;r<16;++r)sacc+=pB1[r]; l_reg+=sacc;
    pw0=(u32x4){PKW(pB0,0),PKW(pB0,2),PKW(pB0,4),PKW(pB0,6)};pw1=(u32x4){PKW(pB0,8),PKW(pB0,10),PKW(pB0,12),PKW(pB0,14)};pw2=(u32x4){PKW(pB1,0),PKW(pB1,2),PKW(pB1,4),PKW(pB1,6)};pw3=(u32x4){PKW(pB1,8),PKW(pB1,10),PKW(pB1,12),PKW(pB1,14)};
    SBAR(); pv(o,vb0+sl_cur,PAF(0),PAF(1),PAF(2),PAF(3)); }
  #undef PKW
  #undef PAF
  #undef VFR
  #undef PIN
  #undef MX3
  #undef GAPA
  #undef GAPB
  #undef EX
  #undef VRD
  #undef KRD
  #undef STEP
  #undef ENDW
  {auto rr=__builtin_amdgcn_permlane32_swap(__float_as_uint(l_reg),__float_as_uint(l_reg),false,false);l_reg=__uint_as_float(rr[0])+__uint_as_float(rr[1]);}
  if(hi==0)wsf[32+r32]=l_reg;asm volatile("s_waitcnt lgkmcnt(0)":::"memory");
  float rli[16];
  #pragma unroll
  for(int r=0;r<16;++r)rli[r]=__builtin_amdgcn_rcpf(wsf[32+crow(r,hi)]);
  bf16*Ow=O+(rowbase+q0+wid*QBLK)*OPITCH+ocol;
  { bf16*stg=(bf16*)(shm+LDS_OST)+wid*2048;
    #pragma unroll
    for(int r=0;r<16;++r){const int orow=crow(r,hi);
      #pragma unroll
      for(int d0=0;d0<2;++d0)stg[orow*64+d0*32+r32]=__float2bfloat16(o[d0][r]*rli[r]);}
    asm volatile("s_waitcnt lgkmcnt(0)":::"memory");
    #pragma unroll
    for(int i=0;i<4;++i){const int row=i*8+(lane>>3),ch=lane&7; const u32x4 v=*(const u32x4*)(stg+row*64+ch*8); ATTN_STORE16(Ow+(long)row*OPITCH+ch*8,v);} }
  asm volatile("s_waitcnt lgkmcnt(0)\n\ts_barrier":::"memory");
  #undef DMA_K
  #undef TROW
  #undef DMA_V
  #undef CMASK
  #undef START
  #undef RESC
  #undef ROT
}
constexpr int ATTN_LDS_BYTES=LDS_BYTES+2048;
#undef SBAR
#undef WAIT_BAR
}
constexpr int NWAVES = 8;
constexpr int DMODEL = 1024, NBATCH = 8, SEQL = 2048, CTXL = 256, RPB = SEQL + CTXL  , MROWS = NBATCH * RPB  ;
constexpr int DFF = 2816, N13 = 2 * DFF, NIN = 2304, NMOD = 9, MODW = NMOD * DMODEL;
constexpr float EPS = 1e-6f;
constexpr float QC2 = 0.125f * 1.4426950408889634f;
constexpr size_t MiB = 1u << 20;
constexpr size_t WS_CTL = 0, CTL_ZERO_BYTES = 1 * MiB;
constexpr size_t WS_MODS = 1 * MiB;
constexpr size_t WS_ROPE = 2 * MiB;
constexpr size_t WS_W = 3 * MiB;
constexpr size_t SZ_W13 = (size_t)N13 * DMODEL * 2, SZ_W2 = (size_t)DMODEL * DFF * 2, SZ_WIN = (size_t)NIN * DMODEL * 2, SZ_WOUT = (size_t)DMODEL * DMODEL * 2;
constexpr size_t OFF_W13A = 0, OFF_W2A = OFF_W13A + SZ_W13, OFF_WIN = OFF_W2A + SZ_W2, OFF_WOUT = OFF_WIN + SZ_WIN, OFF_W13B = OFF_WOUT + SZ_WOUT, OFF_W2B = OFF_W13B + SZ_W13, SZ_WLAYER = OFF_W2B + SZ_W2;
constexpr size_t WS_XS = WS_W + 2 * SZ_WLAYER;
constexpr size_t WS_U = WS_XS + (size_t)MROWS * DMODEL * 4;
constexpr size_t WS_O = WS_U + (size_t)MROWS * DFF * 2;
constexpr size_t WS_END = WS_O + (size_t)MROWS * DMODEL * 2;
static_assert(WS_O == WS_O_BYTES && WS_END == WS_END_BYTES && WS_U == WS_U_BYTES, "slab offsets");
static_assert(WS_XS % 256 == 0 && WS_U % 256 == 0 && WS_O % 256 == 0, "alignment");
constexpr int CW_BAR = 4096;
constexpr int RING_BYTES = 131072, LDSCTL_OFF = RING_BYTES, MISC_OFF = LDSCTL_OFF + 320, LDS_BYTES = 147456;

#define GAS __attribute__((address_space(1)))
#define LAS __attribute__((address_space(3)))
typedef unsigned short bf16;
typedef unsigned v4u __attribute__((ext_vector_type(4)));
typedef unsigned v2u __attribute__((ext_vector_type(2)));
typedef float f32x4 __attribute__((ext_vector_type(4)));
typedef float f32x2 __attribute__((ext_vector_type(2)));
#define LDS_WAIT() asm volatile("s_waitcnt lgkmcnt(0)" ::: "memory")
__device__ __forceinline__ unsigned f2bf(float f) { unsigned u = __builtin_bit_cast(unsigned, f); return (u + 0x7fffu + ((u >> 16) & 1u)) >> 16; }
__device__ __forceinline__ unsigned pk2(float lo, float hi) { return f2bf(lo) | (f2bf(hi) << 16); }
__device__ __forceinline__ float bf2f(unsigned short h) { return __builtin_bit_cast(float, (unsigned)h << 16); }
__device__ __forceinline__ float wave_sum(float v) {
#pragma unroll
    for (int o = 1; o < 64; o <<= 1) v += __shfl_xor(v, o);
    return v;
}
#define RLX_AGENT __ATOMIC_RELAXED, __HIP_MEMORY_SCOPE_AGENT
#define XB_TMO      128
#define XB_XCNT(j)  (256  + 64 * (j))
#define XB_XSUB(j)  (1280 + 64 * (j))
#define XB_XGEN(j)  (2304 + 64 * (j))
#define XB_TOP      3328
#define XB_TOPGEN   3392
#define XCD_BAR_WORDS 3456
#define XB_SPIN_CAP (1u << 18)

__device__ __forceinline__ unsigned xb_ld(unsigned* p)              { return __hip_atomic_load(p, __ATOMIC_RELAXED, __HIP_MEMORY_SCOPE_AGENT); }
__device__ __forceinline__ unsigned xb_add(unsigned* p, unsigned v) { return __hip_atomic_fetch_add(p, v, __ATOMIC_RELAXED, __HIP_MEMORY_SCOPE_AGENT); }
__device__ __forceinline__ unsigned xb_xcc_id() { return (unsigned)__builtin_amdgcn_s_getreg((3 << 11) | 20) & 0xFu; }
#define XB_SPIN(cond, bar) do { unsigned _sp = 0; while (cond) { __builtin_amdgcn_s_sleep(1); \
    if ((++_sp & 255u) == 0u) { if (xb_ld(&(bar)[XB_TMO])) break; if (_sp > XB_SPIN_CAP) { atomicAdd(&(bar)[XB_TMO], 1u); break; } } } } while (0)

struct XcdBarrier {
    unsigned* bar; unsigned x;
    volatile LAS unsigned* st;
};

__device__ __forceinline__ XcdBarrier xcd_barrier_post(unsigned* bar, volatile LAS unsigned* st) {
    XcdBarrier b; b.bar = bar; b.x = xb_xcc_id(); b.st = st;
    if (threadIdx.x == 0) (void)xb_add(&bar[XB_XCNT(b.x)], 1u);
    return b;
}
__device__ __forceinline__ void xcd_barrier_complete(unsigned* bar, unsigned x, unsigned& nloc, unsigned& nx) {
    const unsigned G = gridDim.x * gridDim.y * gridDim.z;
    unsigned sum, cnt, mine, sp = 0u;
    for (;;) {
        sum = 0u; cnt = 0u; mine = 0u;
#pragma unroll
        for (unsigned j = 0; j < 16; ++j) { const unsigned c = xb_ld(&bar[XB_XCNT(j)]); sum += c; cnt += (c > 0u) ? 1u : 0u; mine = (j == x) ? c : mine; }
        if (sum == G) break;
        __builtin_amdgcn_s_sleep(1);
        if ((++sp & 255u) == 0u) { if (xb_ld(&bar[XB_TMO])) break; if (sp > XB_SPIN_CAP) { atomicAdd(&bar[XB_TMO], 1u); break; } }
    }
    nloc = mine > 0u ? mine : 1u; nx = cnt > 0u ? cnt : 1u;
}

__device__ __forceinline__ void xcd_barrier(const XcdBarrier& b) {
    asm volatile("s_waitcnt vmcnt(0)" ::: "memory");
    __syncthreads();
    if (threadIdx.x == 0) {
        unsigned* bar = b.bar;
        __builtin_amdgcn_s_waitcnt(0);
        unsigned nloc = b.st[0], nx = b.st[1];
        if (nloc == 0u) { xcd_barrier_complete(bar, b.x, nloc, nx); b.st[0] = nloc; b.st[1] = nx; }
        const unsigned old = xb_add(&bar[XB_XSUB(b.x)], 1u);
        const unsigned gen = old / nloc;
        if (old + 1u == (gen + 1u) * nloc) {
            __builtin_amdgcn_fence(__ATOMIC_RELEASE, "agent");
            asm volatile("s_waitcnt vmcnt(0)" ::: "memory");
            const unsigned og = xb_add(&bar[XB_TOP], 1u);
            const unsigned tg = og / nx;
            if (og + 1u == (tg + 1u) * nx) xb_add(&bar[XB_TOPGEN], 1u);
            else XB_SPIN(xb_ld(&bar[XB_TOPGEN]) == tg, bar);
            __builtin_amdgcn_fence(__ATOMIC_ACQUIRE, "agent");
            xb_add(&bar[XB_XGEN(b.x)], 1u);
            asm volatile("s_waitcnt vmcnt(0)" ::: "memory");
        } else {
            XB_SPIN(xb_ld(&bar[XB_XGEN(b.x)]) == gen, bar);
            __builtin_amdgcn_fence(__ATOMIC_ACQUIRE, "agent");
            asm volatile("s_waitcnt vmcnt(0)" ::: "memory");
        }
    }
    __syncthreads();
}
struct Args {
    const float* in[21]; float* out; unsigned char* ws; int pad0, pad1;
};
typedef const __attribute__((address_space(4))) Args* ArgsP;
__device__ __forceinline__ ArgsP get_args() { ArgsP p = (ArgsP)__builtin_amdgcn_kernarg_segment_ptr(); asm volatile("" : "+s"(p)); return p; }
struct Frame {
    LAS unsigned char* lds; int tid, lane, wave, vcu, G;
    __device__ __forceinline__ void refresh() { int t = threadIdx.x; asm volatile("" : "+v"(t)); tid = t; lane = t & 63; wave = __builtin_amdgcn_readfirstlane(t >> 6); }
};
template <int MAP> __device__ __forceinline__ int map_dest(int s) {
    if (MAP == 1) { const int bj = s >= DFF ? 1 : 0, r = s - bj * DFF; return (r >> 7) * 256 + bj * 128 + (r & 127); }
    if (MAP == 2) { const int pn = s >> 8, rem = s & 255, wc = rem >> 6, bj = (rem >> 5) & 1, x = rem & 31, hh = pn * 4 + wc;
        if (hh >= 24 && hh < 34) { const int nn = (x >> 4) & 1, fq = (x >> 2) & 3, e = x & 3; return pn * 256 + bj * 128 + wc * 32 + fq * 8 + nn * 4 + e; }
        return pn * 256 + bj * 128 + wc * 32 + x; }
    return s;
}
template <int MAP> __device__ __forceinline__ void p0_transpose_item(const float* W, int K, int N, bf16* WT, LAS float* scr, int item, int lane) {
    const int nblk = N / 32, kb = item / nblk, nb = item % nblk, k0 = 64 * kb, n0 = 32 * nb;
#pragma unroll 8
    for (int i = 0; i < 32; ++i) { const int kk = 2 * i + (lane >> 5); scr[kk * 33 + (lane & 31)] = W[(size_t)(k0 + kk) * N + n0 + (lane & 31)]; }
    LDS_WAIT(); asm volatile("" ::: "memory");
    const int c = lane & 7;
#pragma unroll
    for (int j = 0; j < 4; ++j) { const int n = (lane >> 3) + 8 * j; const LAS float* s = scr + (8 * c) * 33 + n;
        v4u o; o.x = pk2(s[0 * 33], s[1 * 33]); o.y = pk2(s[2 * 33], s[3 * 33]); o.z = pk2(s[4 * 33], s[5 * 33]); o.w = pk2(s[6 * 33], s[7 * 33]);
        *(GAS v4u*)(WT + (size_t)map_dest<MAP>(n0 + n) * K + k0 + 8 * c) = o; }
    LDS_WAIT(); asm volatile("" ::: "memory");
}
__device__ __forceinline__ void p0_mod_unit(const Frame& F, int unit, const float* c, const float* cctx, const float* wmod, const float* bmod, float* mods) {
    const int layer = unit / 72, col0 = (unit % 72) * 128;
    LAS float* sc = (LAS float*)F.lds;
    LAS float* red = sc + 9 * 1024;
    for (int i = F.tid; i < 9 * 1024; i += NWAVES * 64) { const int j = i >> 10, k = i & 1023; const float v = j < 8 ? c[j * 1024 + k] : cctx[k]; sc[i] = v / (1.0f + expf(-v)); }
    __syncthreads();
    const float* W = wmod + (size_t)layer * 1024 * MODW + col0 + 2 * F.lane;
    float a0[9], a1[9];
#pragma unroll
    for (int j = 0; j < 9; ++j) { a0[j] = 0.f; a1[j] = 0.f; }
    const int kw = F.wave * 128;
    for (int kk = 0; kk < 128; kk += 8) {
        f32x2 w[8];
#pragma unroll
        for (int q = 0; q < 8; ++q) w[q] = *(const f32x2*)(W + (size_t)(kw + kk + q) * MODW);
#pragma unroll
        for (int q = 0; q < 8; ++q)
#pragma unroll
            for (int j = 0; j < 9; ++j) { const float s = sc[j * 1024 + kw + kk + q]; a0[j] += s * w[q].x; a1[j] += s * w[q].y; }
    }
#pragma unroll
    for (int j = 0; j < 9; ++j) { red[(F.wave * 9 + j) * 128 + 2 * F.lane] = a0[j]; red[(F.wave * 9 + j) * 128 + 2 * F.lane + 1] = a1[j]; }
    __syncthreads();
    for (int i = F.tid; i < 9 * 128; i += NWAVES * 64) { const int j = i >> 7, cc = i & 127; float s = 0.f;
#pragma unroll
        for (int w = 0; w < 8; ++w) s += red[(w * 9 + j) * 128 + cc];
        mods[(size_t)(layer * 9 + j) * MODW + col0 + cc] = s + bmod[layer * MODW + col0 + cc]; }
    __syncthreads();
}
__device__ __forceinline__ void p0_prologue(Frame F, ArgsP A) {
    F.refresh();
    unsigned char* ws = A->ws;
    if ((int)blockIdx.x < 144) p0_mod_unit(F, (int)blockIdx.x, A->in[1], A->in[3], A->in[4], A->in[5], (float*)(ws + WS_MODS));
    if ((int)blockIdx.x == F.G - 1) {
        float* rc = (float*)(ws + WS_ROPE); float* rs = rc + 1024;
        for (int i = F.tid; i < 1024; i += NWAVES * 64) { const int pos = i >> 4, fi = i & 15; const float inv = powf(10000.0f, -(float)(2 * fi) / 32.0f); const float ang = (float)pos * inv; rc[i] = cosf(ang); rs[i] = sinf(ang); }
    }
    LAS float* scr = (LAS float*)(F.lds + F.wave * 16384);
    const int gw = F.vcu * NWAVES + F.wave, NGW = F.G * NWAVES;
    constexpr int I13 = (DMODEL / 64) * (N13 / 32), I2 = (DFF / 64) * (DMODEL / 32), IIN = (DMODEL / 64) * (NIN / 32), IOUT = (DMODEL / 64) * (DMODEL / 32);
    constexpr int ILAYER = 2 * I13 + 2 * I2 + IIN + IOUT;
    for (int it = gw; it < 2 * ILAYER; it += NGW) {
        const int l = it / ILAYER; int r = it % ILAYER;
        unsigned char* wl = ws + WS_W + (size_t)l * SZ_WLAYER;
        if (r < I13) { p0_transpose_item<1>(A->in[7] + (size_t)l * DMODEL * N13, DMODEL, N13, (bf16*)(wl + OFF_W13A), scr, r, F.lane); continue; } r -= I13;
        if (r < I13) { p0_transpose_item<1>(A->in[18] + (size_t)l * DMODEL * N13, DMODEL, N13, (bf16*)(wl + OFF_W13B), scr, r, F.lane); continue; } r -= I13;
        if (r < I2) { p0_transpose_item<0>(A->in[8] + (size_t)l * DFF * DMODEL, DFF, DMODEL, (bf16*)(wl + OFF_W2A), scr, r, F.lane); continue; } r -= I2;
        if (r < I2) { p0_transpose_item<0>(A->in[19] + (size_t)l * DFF * DMODEL, DFF, DMODEL, (bf16*)(wl + OFF_W2B), scr, r, F.lane); continue; } r -= I2;
        if (r < IIN) { p0_transpose_item<2>(A->in[10] + (size_t)l * DMODEL * NIN, DMODEL, NIN, (bf16*)(wl + OFF_WIN), scr, r, F.lane); continue; } r -= IIN;
        p0_transpose_item<0>(A->in[16] + (size_t)l * DMODEL * DMODEL, DMODEL, DMODEL, (bf16*)(wl + OFF_WOUT), scr, r, F.lane);
    }
}
__device__ __forceinline__ void modnorm_phase(Frame F, ArgsP A, bool first, bool latent_only, int combine  , const float* g, const float* modl  , int chunk_shift) {
    F.refresh();
    float* xs = (float*)(A->ws + WS_XS); bf16* H = (bf16*)A->out;
    const int gw = F.vcu * NWAVES + F.wave, NGW = F.G * NWAVES;
    for (int row = gw; row < MROWS; row += NGW) {
        const int b = row / RPB, t = row - b * RPB; const bool isctx = t >= SEQL; const int j = isctx ? 8 : b;
        if (isctx && latent_only) continue;
        const float* src = first ? (isctx ? A->in[2] + (size_t)(b * CTXL + t - SEQL) * DMODEL : A->in[0] + (size_t)(b * SEQL + t) * DMODEL) : xs + (size_t)row * DMODEL;
        const GAS f32x4* xr = (const GAS f32x4*)src + F.lane;
        f32x4 v[4]; float s2 = 0.f;
#pragma unroll
        for (int q = 0; q < 4; ++q) { v[q] = xr[64 * q]; s2 += (v[q].x * v[q].x + v[q].y * v[q].y) + (v[q].z * v[q].z + v[q].w * v[q].w); }
        if (combine && row >= 16384) {
#pragma unroll
            for (int ch = 0; ch < 8; ++ch) { const GAS f32x4* pr = (const GAS f32x4*)(pg8::part_slab(A->ws, (unsigned char*)A->out, ch, combine == 2) + (size_t)(row - 16384) * DMODEL) + F.lane;
#pragma unroll
                for (int q = 0; q < 4; ++q) v[q] = v[q] + pr[64 * q]; }
            s2 = 0.f; GAS f32x4* xo = (GAS f32x4*)(xs + (size_t)row * DMODEL) + F.lane;
#pragma unroll
            for (int q = 0; q < 4; ++q) { xo[64 * q] = v[q]; s2 += (v[q].x * v[q].x + v[q].y * v[q].y) + (v[q].z * v[q].z + v[q].w * v[q].w); }
        }
        const float rstd = 1.0f / sqrtf(wave_sum(s2) * (1.0f / DMODEL) + EPS);
        const float* sh = modl + (size_t)j * MODW + chunk_shift * DMODEL; const float* scl = sh + DMODEL;
        if (first) { GAS f32x4* xo = (GAS f32x4*)(xs + (size_t)row * DMODEL) + F.lane;
#pragma unroll
            for (int q = 0; q < 4; ++q) xo[64 * q] = v[q]; }
        GAS unsigned long long* o8 = (GAS unsigned long long*)(H + (size_t)row * DMODEL) + F.lane;
#pragma unroll
        for (int q = 0; q < 4; ++q) { const int col = 4 * F.lane + 256 * q;
            const f32x4 gg = *(const f32x4*)(g + col), sc = *(const f32x4*)(scl + col), sf = *(const f32x4*)(sh + col);
            const f32x4 h = v[q] * rstd * gg * (sc + 1.0f) + sf;
            o8[64 * q] = (unsigned long long)pk2(h.x, h.y) | ((unsigned long long)pk2(h.z, h.w) << 32); }
    }
}
__device__ __forceinline__ void onorm_phase(Frame F, ArgsP A, bool latent_only, const float* ga, const float* gb) {
    F.refresh();
    bf16* O = (bf16*)(A->ws + WS_O);
    const int gw = F.vcu * NWAVES + F.wave, NGW = F.G * NWAVES;
    for (int row = gw; row < MROWS; row += NGW) {
        const int t = row % RPB; if (t >= SEQL && latent_only) continue;
        GAS v4u* p = (GAS v4u*)(O + (size_t)row * DMODEL) + F.lane;
        v4u wa = p[0], wb = p[64]; float xa[8], xb[8]; float sa = 0.f, sb = 0.f;
#pragma unroll
        for (int q = 0; q < 4; ++q) { xa[2 * q] = __builtin_bit_cast(float, wa[q] << 16); xa[2 * q + 1] = __builtin_bit_cast(float, wa[q] & 0xffff0000u);
            xb[2 * q] = __builtin_bit_cast(float, wb[q] << 16); xb[2 * q + 1] = __builtin_bit_cast(float, wb[q] & 0xffff0000u); }
#pragma unroll
        for (int q = 0; q < 8; ++q) { sa += xa[q] * xa[q]; sb += xb[q] * xb[q]; }
        const float ra = 1.0f / sqrtf(wave_sum(sa) * (1.0f / 512.0f) + EPS), rb = 1.0f / sqrtf(wave_sum(sb) * (1.0f / 512.0f) + EPS);
        const f32x4 a0 = *(const f32x4*)(ga + 8 * F.lane), a1 = *(const f32x4*)(ga + 8 * F.lane + 4), b0 = *(const f32x4*)(gb + 8 * F.lane), b1 = *(const f32x4*)(gb + 8 * F.lane + 4);
        v4u oa, ob;
        oa.x = pk2(xa[0] * ra * a0.x, xa[1] * ra * a0.y); oa.y = pk2(xa[2] * ra * a0.z, xa[3] * ra * a0.w); oa.z = pk2(xa[4] * ra * a1.x, xa[5] * ra * a1.y); oa.w = pk2(xa[6] * ra * a1.z, xa[7] * ra * a1.w);
        ob.x = pk2(xb[0] * rb * b0.x, xb[1] * rb * b0.y); ob.y = pk2(xb[2] * rb * b0.z, xb[3] * rb * b0.w); ob.z = pk2(xb[4] * rb * b1.x, xb[5] * rb * b1.y); ob.w = pk2(xb[6] * rb * b1.z, xb[7] * rb * b1.w);
        p[0] = oa; p[64] = ob;
    }
}
__device__ __forceinline__ void final_phase(Frame F, ArgsP A) {
    F.refresh();
    const float* xs = (const float*)(A->ws + WS_XS); const float* g = A->in[20];
    const int gw = F.vcu * NWAVES + F.wave, NGW = F.G * NWAVES;
    for (int r = gw; r < NBATCH * SEQL; r += NGW) {
        const int b = r / SEQL, t = r - b * SEQL;
        const GAS f32x4* xr = (const GAS f32x4*)(xs + (size_t)(b * RPB + t) * DMODEL) + F.lane;
        f32x4 v[4]; float s2 = 0.f;
#pragma unroll
        for (int q = 0; q < 4; ++q) { v[q] = xr[64 * q]; s2 += (v[q].x * v[q].x + v[q].y * v[q].y) + (v[q].z * v[q].z + v[q].w * v[q].w); }
        const float rstd = 1.0f / sqrtf(wave_sum(s2) * (1.0f / DMODEL) + EPS);
        GAS f32x4* o = (GAS f32x4*)(A->out + (size_t)r * DMODEL) + F.lane;
#pragma unroll
        for (int q = 0; q < 4; ++q) o[64 * q] = v[q] * rstd * *(const f32x4*)(g + 4 * F.lane + 256 * q);
    }
}
__device__ __forceinline__ void attn_phase(const Frame& F, ArgsP A, int layer, bool do_ctx, char* lds) {
    const attn_body::bf16* QKV = (const attn_body::bf16*)(A->ws + WS_U); attn_body::bf16* O = (attn_body::bf16*)(A->ws + WS_O);
    const float* rpb = A->in[11] + (size_t)layer * 8 * 15 * 31;
#ifndef NO_MODE0
    {
        const int per = (512 + F.G - 1) / F.G, perc = do_ctx ? (128 + F.G - 1) / F.G : 0;
        for (int i = 0; i < per + perc; ++i) {
            int b, q0, qcol, kcol, vcol, ocol, tb, nt;
            if (i < per) { const int u = per * F.vcu + i; if (u >= 512) continue; const int qb = u & 7, hq = (u >> 3) & 7, kvh = hq >> 2; b = u >> 6; q0 = qb * 256; qcol = 1536 + hq * 64; kcol = 2048 + kvh * 64; vcol = 2176 + kvh * 64; ocol = 512 + hq * 64; tb = 0; nt = 36; }
            else { const int uc = perc * F.vcu + (i - per); if (uc >= 128) continue; const int v = uc & 63, h = v & 7; b = v >> 3; q0 = 2048; tb = 2048; nt = 4;
                if (uc < 64) { qcol = 1536 + h * 64; kcol = 2048 + (h >> 2) * 64; vcol = 2176 + (h >> 2) * 64; ocol = 512 + h * 64; }
                else { qcol = h * 64; kcol = 512 + h * 64; vcol = 1024 + h * 64; ocol = h * 64; } }
            attn_body::attn_unit<0, 8>(b, q0, qcol, kcol, vcol, ocol, tb, nt, 0, nullptr, QKV, O, lds);
        }
    }
#endif
#ifndef NO_MODE1
    for (int i = 0; i < (512 + F.G - 1) / F.G; ++i) {
        const int u = ((512 + F.G - 1) / F.G) * F.vcu + i; if (u >= 512) continue; const int qb = u & 7, h = (u >> 3) & 7, b = u >> 6;
        const int kr0 = min(max(4 * qb - 4, 0), 20);
        attn_body::attn_unit<1, 8>(b, qb * 256, h * 64, 512 + h * 64, 1024 + h * 64, h * 64, 0, 16, kr0, rpb + h * 15 * 31, QKV, O, lds);
    }
#endif
}

__global__ void __launch_bounds__(NWAVES * 64, 2) fwd_megakernel(Args A_unused_directly) {
    extern __shared__ __attribute__((aligned(16))) unsigned char lds[];
    cg::grid_group grid = cg::this_grid();
    Frame F;
    F.lds = (LAS unsigned char*)lds;
    F.refresh();
    F.G = gridDim.x; { const int bx = blockIdx.x; F.vcu = (F.G % 8 == 0) ? (bx % 8) * (F.G / 8) + bx / 8 : bx; }
    for (int u = F.tid; u < (LDS_BYTES - LDSCTL_OFF) / 4; u += NWAVES * 64) ((LAS unsigned*)(F.lds + LDSCTL_OFF))[u] = 0u;
    __syncthreads();
    XcdBarrier bar = xcd_barrier_post((unsigned*)(get_args()->ws + WS_CTL) + CW_BAR, (volatile LAS unsigned*)(F.lds + MISC_OFF) + 8);
#ifdef ALL_CG_SYNC
#define GRID_BAR() grid.sync()
#else
#define GRID_BAR() xcd_barrier(bar)
#endif

    p0_prologue(F, get_args());
#ifdef PROBE_P0X2
    __syncthreads(); p0_prologue(F, A);
#endif
    grid.sync();
    for (int l = 0; l < 2; ++l) {
        const bool last = (l == 1);
#define MODL(A_) ((const float*)((A_)->ws + WS_MODS) + (size_t)l * 9 * MODW)
#define WL(A_) ((A_)->ws + WS_W + (size_t)l * SZ_WLAYER)
        for (int f = 0; f < 2; ++f) {
            const bool lat = last && f == 1;
            { ArgsP A = get_args(); modnorm_phase(F, A, l == 0 && f == 0, lat, (l == 1 && f == 0) ? 1 : ((l == 0 && f == 1) ? 2 : 0)  , (f == 0 ? A->in[6] : A->in[17]) + l * DMODEL, MODL(A), f == 0 ? 0 : 6); }
#ifdef PROBE_NORMX2
            if (f == 1) { GRID_BAR(); ArgsP A = get_args(); modnorm_phase(F, A, false, lat, false, A->in[17] + l * DMODEL, MODL(A), 6); }
#endif
            GRID_BAR();
            {
                ArgsP A = get_args(); unsigned char* ws = A->ws; unsigned char* wl = WL(A);
                pg8::Gemm g{(const pg8::bf16_t*)A->out, (const pg8::bf16_t*)(wl + (f == 0 ? OFF_W13A : OFF_W13B)), MROWS, N13, DMODEL};
                pg8::Sched2 S; S.init(N13, DMODEL, F.G, (int)blockIdx.x, lat, false);
                pg8::EpiSwiglu E{(pg8::bf16_t*)(ws + WS_U), DFF};
#ifndef NO_G1
                pg8::gemm_phase<pg8::EpiSwiglu, pg8::Sched2, true, true>(F.lds, g, S, E);
#endif
#ifdef PROBE_G1X2
                GRID_BAR(); pg8::gemm_phase<pg8::EpiSwiglu, pg8::Sched2, true, true>(F.lds, g, S, E);
#endif
            }
            GRID_BAR();
            {
                ArgsP A = get_args(); unsigned char* ws = A->ws; unsigned char* wl = WL(A); const float* modl = MODL(A);
                pg8::Gemm g{(const pg8::bf16_t*)(ws + WS_U), (const pg8::bf16_t*)(wl + (f == 0 ? OFF_W2A : OFF_W2B)), MROWS, DMODEL, DFF};
                pg8::Sched2 S; S.init(DMODEL, DFF, F.G, (int)blockIdx.x, lat, true);
                pg8::EpiResid E{(float*)(ws + WS_XS), modl + (f == 0 ? 2 : 8) * DMODEL, 0.5f, ws, (unsigned char*)A->out, 0};
#ifndef NO_G2
                pg8::gemm_phase<pg8::EpiResid, pg8::Sched2, true, true>(F.lds, g, S, E);
#endif
#ifdef PROBE_G2X3
                if (!(l == 1 && f == 1)) { GRID_BAR(); E.s = -0.5f; S.cpu = 0; S.full = S.nwg; pg8::gemm_phase<pg8::EpiResid, pg8::Sched2, true, true>(F.lds, g, S, E);
                GRID_BAR(); E.s = 0.5f; pg8::gemm_phase<pg8::EpiResid, pg8::Sched2, true, true>(F.lds, g, S, E); }
#endif
            }
            GRID_BAR();
            if (f == 0) {
                { ArgsP A = get_args(); modnorm_phase(F, A, false, false, 1  , A->in[9] + l * DMODEL, MODL(A), 3); }
                GRID_BAR();
                {
                    ArgsP A = get_args(); unsigned char* ws = A->ws; unsigned char* wl = WL(A); const float* rc = (const float*)(ws + WS_ROPE); const float* rs = rc + 1024;
                    pg8::Gemm g{(const pg8::bf16_t*)A->out, (const pg8::bf16_t*)(wl + OFF_WIN), MROWS, NIN, DMODEL};
                    pg8::Sched2 S; S.init(NIN, DMODEL, F.G, (int)blockIdx.x, false, false);
                    pg8::EpiQkv E{(pg8::bf16_t*)(ws + WS_U), A->in[12] + l * 64, A->in[13] + l * 64, rc, rs, QC2, EPS};
#ifndef NO_GIN
                    pg8::gemm_phase<pg8::EpiQkv, pg8::Sched2, true, true>(F.lds, g, S, E);
#endif
#ifdef PROBE_GINX2
                    GRID_BAR(); pg8::gemm_phase<pg8::EpiQkv, pg8::Sched2, true, true>(F.lds, g, S, E);
#endif
                }
                GRID_BAR();
#ifndef NO_ATTN
                attn_phase(F, get_args(), l, !last, (char*)lds);
#endif
#ifdef PROBE_ATTNX2
                GRID_BAR(); attn_phase(F, get_args(), l, !last, (char*)lds);
#endif
                GRID_BAR();
                { ArgsP A = get_args(); onorm_phase(F, A, last, A->in[14] + l * 512, A->in[15] + l * 512); }
                GRID_BAR();
                {
                    ArgsP A = get_args(); unsigned char* ws = A->ws; unsigned char* wl = WL(A); const float* modl = MODL(A);
                    pg8::Gemm g{(const pg8::bf16_t*)(ws + WS_O), (const pg8::bf16_t*)(wl + OFF_WOUT), MROWS, DMODEL, DMODEL};
                    pg8::Sched2 S; S.init(DMODEL, DMODEL, F.G, (int)blockIdx.x, last, true);
                    pg8::EpiResid E{(float*)(ws + WS_XS), modl + 5 * DMODEL, 1.0f, ws, (unsigned char*)A->out, 1};
#ifndef NO_GOUT
                    pg8::gemm_phase<pg8::EpiResid, pg8::Sched2, true, true>(F.lds, g, S, E);
#endif
                }
                GRID_BAR();
            }
        }
    }
    final_phase(F, get_args());
}

extern "C" void kernel_launch(void* const* d_in, const int* in_sizes, int n_in, void* d_out, int out_size, void* d_ws, size_t ws_size, hipStream_t stream) {
    static int grid = 0;
    if (grid == 0) {
        if (n_in != 21 || out_size != NBATCH * SEQL * DMODEL || ws_size < WS_END + pg8::SLAB_BYTES) { fprintf(stderr, "kernel_launch: unexpected shapes (n_in %d, out %d, ws %zu, need %zu)\n", n_in, out_size, ws_size, (size_t)WS_END); grid = -1; return; }
        int dev = 0, cus = 0, per_cu = 0;
        if (hipGetDevice(&dev) != hipSuccess || hipDeviceGetAttribute(&cus, hipDeviceAttributeMultiprocessorCount, dev) != hipSuccess) { grid = -1; return; }
        if (hipFuncSetAttribute((const void*)fwd_megakernel, hipFuncAttributeMaxDynamicSharedMemorySize, LDS_BYTES) != hipSuccess) { fprintf(stderr, "kernel_launch: hipFuncSetAttribute failed\n"); grid = -1; return; }
        if (hipOccupancyMaxActiveBlocksPerMultiprocessor(&per_cu, (const void*)fwd_megakernel, NWAVES * 64, LDS_BYTES) != hipSuccess || per_cu < 1) { fprintf(stderr, "kernel_launch: occupancy query says %d blocks per CU\n", per_cu); (void)hipGetLastError(); grid = -1; return; }
        grid = cus;
    }
    if (grid < 0) return;
    (void)hipMemsetAsync((char*)d_ws + WS_CTL, 0, CTL_ZERO_BYTES, stream);
    Args a{};
    for (int i = 0; i < 21; ++i) a.in[i] = (const float*)d_in[i];
    a.out = (float*)d_out; a.ws = (unsigned char*)d_ws;
    void* args[] = {&a};
    hipError_t e = hipLaunchCooperativeKernel((const void*)fwd_megakernel, dim3(grid), dim3(NWAVES * 64), args, LDS_BYTES, stream);
    if (e != hipSuccess) fprintf(stderr, "kernel_launch: cooperative launch failed: %s (grid %d)\n", hipGetErrorString(e), grid);
}
```

```cpp
#include <hip/hip_runtime.h>
#include <hip/hip_bf16.h>
#include <hip/hip_cooperative_groups.h>
#include <cstdio>
#include <cstdint>
#include <cmath>
namespace cg = cooperative_groups;
#define WS_O_BYTES 265289728ull
#define WS_END_BYTES 303038464ull
#define WS_U_BYTES 161480704ull
namespace pg8 {
#define PG8_LAS __attribute__((address_space(3)))
typedef unsigned short bf16_t;
typedef short bf16x8 __attribute__((ext_vector_type(8)));
typedef float f32x4 __attribute__((ext_vector_type(4)));
typedef unsigned u32x4 __attribute__((ext_vector_type(4)));
constexpr int BM = 256, BK = 64, HALF = 128, HTB = HALF * BK * 2  , STAGE_BYTES = 8 * HTB, NXCD = 8, WGM = 8;

__host__ __device__ __forceinline__ int lds_byte(int r, int c) { const int st = (r >> 4) * 2 + (c >> 5), rr = r & 15, cc = c & 31, ob = rr * 64 + cc * 2; return st * 1024 + (ob ^ (((ob >> 9) & 1) << 5)); }
__host__ __device__ __forceinline__ void stage_rc(int b, int& R, int& C) { const int st = b / 1024, sb = b % 1024, swz = sb ^ (((sb >> 9) & 1) << 5); R = (st >> 1) * 16 + swz / 64; C = (st & 1) * 32 + (swz % 64) / 2; }
__host__ __device__ __forceinline__ int perm32(int rho) { const int n = rho >> 4, i = rho & 15; return 8 * (i >> 2) + 4 * n + (i & 3); }

struct Unit { int pm, pn, k0, nk, ch, part; };
struct Gemm { const bf16_t* A; const bf16_t* Bt; int M, N, K; };

struct StaticOrder {
    int nM, nN, nwg, G, c;
    __host__ __device__ void init(int M, int N, int G_, int c_) { nM = M / BM; nN = N / BM; nwg = nM * nN; G = G_; c = c_; }
    __host__ __device__ bool next(int i, Unit& u) const {
        const long L = (long)i * G + c; if (L >= nwg) return false;
        int wgid = (int)L; { const int q = nwg / NXCD, r = nwg % NXCD, xcd = wgid % NXCD, off = wgid / NXCD; wgid = (xcd < r ? xcd * (q + 1) : r * (q + 1) + (xcd - r) * q) + off; }
        const int nig = WGM * nN, gid = wgid / nig, fm = gid * WGM, gsz = (nM - fm) < WGM ? (nM - fm) : WGM;
        u.pm = fm + ((wgid % nig) % gsz); u.pn = (wgid % nig) / gsz; u.k0 = 0; u.nk = 0; u.ch = 0; u.part = 0; return true;
    }
    __device__ __forceinline__ void a_ready(const Unit&) const {}
    __device__ __forceinline__ void done(const Unit&) const {}
};

__device__ __forceinline__ unsigned cvt_pk_bf16(float lo, float hi) { unsigned r; asm volatile("v_cvt_pk_bf16_f32 %0, %1, %2" : "=v"(r) : "v"(lo), "v"(hi)); return r; }
typedef float f32x2 __attribute__((ext_vector_type(2)));
typedef unsigned u32x2 __attribute__((ext_vector_type(2)));
constexpr size_t SLAB_BYTES = (size_t)2048 * 1024 * 4, SLAB_WS_O = (size_t)WS_O_BYTES, SLAB_WS_END = (size_t)WS_END_BYTES, SLAB_OUT = (size_t)36 << 20;
__device__ __forceinline__ float* part_slab(unsigned char* ws, unsigned char* outb, int ch, int sel) {
    if (sel) return (float*)(ws + WS_U_BYTES + (size_t)ch * SLAB_BYTES);
    return (float*)(ch < 4 ? ws + SLAB_WS_O + (size_t)ch * SLAB_BYTES : (ch == 4 ? ws + SLAB_WS_END : outb + SLAB_OUT + (size_t)(ch - 5) * SLAB_BYTES));
}
struct EpiSwiglu {
    static constexpr bool PERM = true, AFTER_DRAIN = false;
    bf16_t* U; int ldu;
    __device__ __forceinline__ void operator()(const f32x4 (&acc)[2][2][4][2], const Unit& u, int wr, int wc, int fr, int fq) const {
        const int row0 = u.pm * BM + wr * 64 + fr, col0 = u.pn * HALF + wc * 32 + 8 * fq;
#pragma unroll
        for (int ai = 0; ai < 2; ++ai)
#pragma unroll
            for (int m = 0; m < 4; ++m) {
                float r[8];
#pragma unroll
                for (int n = 0; n < 2; ++n)
#pragma unroll
                    for (int e = 0; e < 4; ++e) { const float a = acc[ai][0][m][n][e], g = acc[ai][1][m][n][e];
                        r[n * 4 + e] = a * g * __builtin_amdgcn_rcpf(1.0f + __builtin_amdgcn_exp2f(-1.4426950408889634f * g)); }
                u32x4 w; w.x = cvt_pk_bf16(r[0], r[1]); w.y = cvt_pk_bf16(r[2], r[3]); w.z = cvt_pk_bf16(r[4], r[5]); w.w = cvt_pk_bf16(r[6], r[7]);
                *(u32x4*)(U + (size_t)(row0 + ai * HALF + m * 16) * ldu + col0) = w; }
    }
};
struct EpiResid {
    static constexpr bool PERM = false, AFTER_DRAIN = false;
    float* X; const float* gate; float s;
    unsigned char* ws; unsigned char* outb; int sel;
    __device__ __forceinline__ void operator()(const f32x4 (&acc)[2][2][4][2], const Unit& u, int wr, int wc, int fr, int fq) const {
        const int j = (u.pm % 9 == 8) ? 8 : u.pm / 9;
        const int row0 = u.pm * BM + wr * 64 + fr, col0 = u.pn * BM + wc * 32 + 4 * fq;
        const float* gp = gate + (size_t)j * 9216 + col0;
        float* slab = u.part ? part_slab(ws, outb, u.ch, sel) - (size_t)16384 * 1024 : X;
        f32x4 gv[2][2];
#pragma unroll
        for (int bj = 0; bj < 2; ++bj)
#pragma unroll
            for (int n = 0; n < 2; ++n) gv[bj][n] = *(const f32x4*)(gp + bj * HALF + n * 16) * s;
#pragma unroll
        for (int ai = 0; ai < 2; ++ai)
#pragma unroll
            for (int m = 0; m < 4; ++m) { float* rowp = X + (size_t)(row0 + ai * HALF + m * 16) * 1024 + col0;
#pragma unroll
                for (int bj = 0; bj < 2; ++bj)
#pragma unroll
                    for (int n = 0; n < 2; ++n) { float* pf = rowp + bj * HALF + n * 16; const f32x4 d = gv[bj][n] * acc[ai][bj][m][n];
                        if (u.part) *(f32x4*)(slab + (pf - X)) = d;
                        else { f32x4* p = (f32x4*)pf; *p = *p + d; } }
                if (m & 1) asm volatile("" ::: "memory"); }
    }
};
struct EpiQkv {
    static constexpr bool PERM = true, AFTER_DRAIN = false;
    bf16_t* QKV; const float* qn; const float* kn; const PG8_LAS float* rc; const PG8_LAS float* rs; float c2; float eps;
    __device__ __forceinline__ void operator()(const f32x4 (&acc)[2][2][4][2], const Unit& u, int wr, int wc, int fr, int fq) const {
        const int hh = u.pn * 4 + wc;
        const bool isq = (hh < 8) || (hh >= 24 && hh < 32), nrm = (hh >= 24 && hh < 34);
        const float* gn = (hh < 32) ? qn : kn;
        const int tq = u.pm % 9; const bool latent = tq != 8; const int tbase = tq * 256;
        f32x4 gv[2][2];
#pragma unroll
        for (int bj = 0; bj < 2; ++bj)
#pragma unroll
            for (int n = 0; n < 2; ++n) gv[bj][n] = nrm ? *(const f32x4*)(gn + 32 * bj + 16 * n + 4 * fq) : (f32x4){1.f, 1.f, 1.f, 1.f};
        const float osc = isq ? c2 : 1.0f;
#pragma unroll
        for (int ai = 0; ai < 2; ++ai)
#pragma unroll
            for (int m = 0; m < 4; ++m) {
                const int rit = ai * HALF + wr * 64 + m * 16 + fr; const size_t row = (size_t)u.pm * BM + rit;
                f32x4 v[2][2];
#pragma unroll
                for (int bj = 0; bj < 2; ++bj)
#pragma unroll
                    for (int n = 0; n < 2; ++n) v[bj][n] = acc[ai][bj][m][n];
                if (nrm) {
                    float ss = 0.f;
#pragma unroll
                    for (int bj = 0; bj < 2; ++bj)
#pragma unroll
                        for (int n = 0; n < 2; ++n) ss += (v[bj][n][0] * v[bj][n][0] + v[bj][n][1] * v[bj][n][1]) + (v[bj][n][2] * v[bj][n][2] + v[bj][n][3] * v[bj][n][3]);
                    ss += __shfl_xor(ss, 16); ss += __shfl_xor(ss, 32);
                    const float r = 1.0f / sqrtf(ss * (1.0f / 64.0f) + eps);
#pragma unroll
                    for (int bj = 0; bj < 2; ++bj)
#pragma unroll
                        for (int n = 0; n < 2; ++n) v[bj][n] = v[bj][n] * r * gv[bj][n];
                    if (latent) {
                        const int t = tbase + rit, pr = t >> 6, pc = t & 63;
#pragma unroll
                        for (int bj = 0; bj < 2; ++bj) { const int pos = bj ? pc : pr;
                            const f32x4 co = *(const PG8_LAS f32x4*)(rc + pos * 16 + 4 * fq), si = *(const PG8_LAS f32x4*)(rs + pos * 16 + 4 * fq);
                            const f32x4 x1 = v[bj][0], x2 = v[bj][1];
                            v[bj][0] = x1 * co - x2 * si; v[bj][1] = x2 * co + x1 * si; }
                    }
                }
                if (nrm) {
                    bf16_t* op = QKV + row * 2304 + hh * 64 + 4 * fq;
#pragma unroll
                    for (int bj = 0; bj < 2; ++bj)
#pragma unroll
                        for (int n = 0; n < 2; ++n) { const f32x4 o = v[bj][n] * osc; u32x2 w; w.x = cvt_pk_bf16(o[0], o[1]); w.y = cvt_pk_bf16(o[2], o[3]); *(u32x2*)(op + 32 * bj + 16 * n) = w; }
                } else {
                    bf16_t* op = QKV + row * 2304 + hh * 64 + 8 * fq;
#pragma unroll
                    for (int bj = 0; bj < 2; ++bj) { const f32x4 o0 = v[bj][0] * osc, o1 = v[bj][1] * osc; u32x4 w; w.x = cvt_pk_bf16(o0[0], o0[1]); w.y = cvt_pk_bf16(o0[2], o0[3]); w.z = cvt_pk_bf16(o1[0], o1[1]); w.w = cvt_pk_bf16(o1[2], o1[3]); *(u32x4*)(op + 32 * bj) = w; }
                }
                asm volatile("" ::: "memory");
            }
    }
};
struct Sched2 {
    int nM, nN, nwg, G, c, nt, full, cpu; bool skip;
    __device__ __forceinline__ void init(int N, int K, int G_, int c_, bool latent_only, bool split) {
        nM = latent_only ? 64 : 72; nN = N / BM; nwg = nM * nN; G = G_; c = c_; nt = K / BK; skip = latent_only; full = nwg; cpu = 0;
        if (split) { const int rem = nwg % G; if (rem == 32 && nwg == 288 && G == 256 && (nt / 2) >= G / rem)   { full = nwg - rem; cpu = G / rem; } }
    }
    __device__ __forceinline__ bool next(int i, Unit& u) const {
        const int L = i * G + c;
        int wgid, k0 = 0, nk = nt, ch = 0, part = 0;
        if (L < full) { wgid = L; const int q = full / NXCD, r = full % NXCD, xcd = wgid % NXCD, off = wgid / NXCD; wgid = (xcd < r ? xcd * (q + 1) : r * (q + 1) + (xcd - r) * q) + off; }
        else if (cpu && L < full + G) { const int j = L - full; ch = j % cpu; wgid = full + j / cpu;
            const int pairs = nt / 2, base = pairs / cpu, ext = pairs % cpu; k0 = 2 * (ch * base + (ch < ext ? ch : ext)); nk = 2 * (base + (ch < ext ? 1 : 0)); part = 1; }
        else return false;
        const int nig = WGM * nN, gid = wgid / nig, fm = gid * WGM, gsz = (nM - fm) < WGM ? (nM - fm) : WGM;
        int pm = fm + ((wgid % nig) % gsz); const int pn = (wgid % nig) / gsz;
        if (skip) pm += pm >> 3;
        u.pm = pm; u.pn = pn; u.k0 = k0; u.nk = nk; u.ch = ch; u.part = part;
        return true;
    }
    __device__ __forceinline__ void a_ready(const Unit&) const {}
    __device__ __forceinline__ void done(const Unit&) const {}
};
template <class Epi, class Sched, bool ALIGN_EPI = false, bool SP2 = false>
__device__ __forceinline__ void gemm_phase(PG8_LAS unsigned char* lds, const Gemm g, const Sched& S, const Epi& E) {
    int tid_ = threadIdx.x; asm volatile("" : "+v"(tid_));
    const int tid = tid_, wid = __builtin_amdgcn_readfirstlane(tid >> 6), lane = tid & 63, wr = wid >> 2, wc = wid & 3, fr = lane & 15, fq = lane >> 4;
    const int K = g.K;
    unsigned voffA[2], voffB[2];
#pragma unroll
    for (int i = 0; i < 2; ++i) { int R, C; stage_rc(tid * 16 + i * 8192, R, C); const int Rb = Epi::PERM ? ((R & ~31) + perm32(R & 31)) : R;
        voffA[i] = (unsigned)(R * K + C) * 2u; voffB[i] = (unsigned)(Rb * K + C) * 2u; }
    const size_t kstep = (size_t)(BK * 2);
    const size_t hstep = (size_t)HALF * K * 2;
    const size_t tstep = 2 * hstep;
    const unsigned ldsw = (unsigned)wid * 1024u;
    const int aoff = lds_byte(wr * 64 + fr, fq * 8), boff = lds_byte(wc * 32 + fr, fq * 8);
#define PG8_SA(b, h) (((b) * 2 + (h)) * HTB)
#define PG8_SB(b, h) ((4 + (b) * 2 + (h)) * HTB)
#define PG8_STAGE(bufoff, gbase, voff) do { _Pragma("unroll") for (int _i = 0; _i < 2; ++_i) \
        __builtin_amdgcn_global_load_lds((const unsigned*)((const char*)(gbase) + (voff)[_i]), (PG8_LAS unsigned*)(lds + (bufoff) + ldsw + _i * 8192), 16, 0, 0); } while (0)
#define PG8_LDA(dst, b, h) do { _Pragma("unroll") for (int m = 0; m < 4; ++m) _Pragma("unroll") for (int k = 0; k < 2; ++k) dst[m][k] = *(const PG8_LAS bf16x8*)(lds + PG8_SA(b, h) + aoff + m * 2048 + k * 1024); } while (0)
#define PG8_LDB(dst, b, h) do { _Pragma("unroll") for (int n = 0; n < 2; ++n) _Pragma("unroll") for (int k = 0; k < 2; ++k) dst[n][k] = *(const PG8_LAS bf16x8*)(lds + PG8_SB(b, h) + boff + n * 2048 + k * 1024); } while (0)
#define PG8_MMA(ai, bj, At, Bt) do { __builtin_amdgcn_s_setprio(1); _Pragma("unroll") for (int m = 0; m < 4; ++m) _Pragma("unroll") for (int n = 0; n < 2; ++n) _Pragma("unroll") for (int k = 0; k < 2; ++k) \
        acc[ai][bj][m][n] = __builtin_amdgcn_mfma_f32_16x16x32_bf16(Bt[n][k], At[m][k], acc[ai][bj][m][n], 0, 0, 0); __builtin_amdgcn_s_setprio(0); } while (0)
#define PG8_WAIT_V(n) asm volatile("s_waitcnt vmcnt(" #n ")" ::: "memory")
#define PG8_WAIT_L(n) asm volatile("s_waitcnt lgkmcnt(" #n ")" ::: "memory")
#define PG8_BAR __builtin_amdgcn_s_barrier()
#define PG8_SCHED __builtin_amdgcn_sched_barrier(0)
    Unit cur, nxt; int ui = 0;
    if (!S.next(0, cur)) return;
    f32x4 acc[2][2][4][2];
#pragma unroll
    for (int a = 0; a < 2; ++a)
#pragma unroll
        for (int b = 0; b < 2; ++b)
#pragma unroll
            for (int m = 0; m < 4; ++m)
#pragma unroll
                for (int n = 0; n < 2; ++n) acc[a][b][m][n] = (f32x4){0.f, 0.f, 0.f, 0.f};
    bf16x8 At[4][2], B0[2][2], B1[2][2];
    const char* cA = (const char*)g.A + (size_t)cur.pm * tstep + (size_t)cur.k0 * kstep; const char* cB = (const char*)g.Bt + (size_t)cur.pn * tstep + (size_t)cur.k0 * kstep;
    S.a_ready(cur);
    if constexpr (SP2) {
        PG8_STAGE(PG8_SB(0, 0), cB, voffB); PG8_STAGE(PG8_SB(0, 1), cB + hstep, voffB); PG8_STAGE(PG8_SA(0, 0), cA, voffA); PG8_STAGE(PG8_SA(0, 1), cA + hstep, voffA);
        if (wr == 1) PG8_BAR;
        PG8_WAIT_V(2); PG8_BAR;
        PG8_STAGE(PG8_SB(1, 0), cB + kstep, voffB); PG8_STAGE(PG8_SA(1, 0), cA + kstep, voffA); PG8_STAGE(PG8_SB(1, 1), cB + hstep + kstep, voffB);
        PG8_WAIT_V(6); PG8_BAR;
    } else {
        PG8_STAGE(PG8_SB(0, 0), cB, voffB); PG8_STAGE(PG8_SA(0, 0), cA, voffA); PG8_STAGE(PG8_SB(0, 1), cB + hstep, voffB); PG8_STAGE(PG8_SA(0, 1), cA + hstep, voffA);
        if (wr == 1) PG8_BAR;
        PG8_WAIT_V(4); PG8_BAR;
        PG8_STAGE(PG8_SB(1, 0), cB + kstep, voffB); PG8_STAGE(PG8_SA(1, 0), cA + kstep, voffA); PG8_STAGE(PG8_SB(1, 1), cB + hstep + kstep, voffB);
        PG8_WAIT_V(6); PG8_BAR;
    }
    for (;;) {
        const bool has_next = S.next(ui + 1, nxt);
        const char* nA = has_next ? (const char*)g.A + (size_t)nxt.pm * tstep + (size_t)nxt.k0 * kstep : cA; const char* nB = has_next ? (const char*)g.Bt + (size_t)nxt.pn * tstep + (size_t)nxt.k0 * kstep : cB;
        const int nt = cur.nk;
        for (int t = 0; t < nt; t += 2) {
            const bool last = (t == nt - 2);
            const char* a1 = cA + (size_t)(t + 1) * kstep;
            const char* a2 = last ? nA : cA + (size_t)(t + 2) * kstep; const char* b2 = last ? nB : cB + (size_t)(t + 2) * kstep;
            const char* a3 = a2 + kstep; const char* b3 = b2 + kstep;
            if (last && has_next) S.a_ready(nxt);
            if constexpr (SP2) {
            PG8_LDB(B0, 0, 0); PG8_LDB(B1, 0, 1); PG8_SCHED; PG8_LDA(At, 0, 0); PG8_STAGE(PG8_SA(1, 1), a1 + hstep, voffA);
            PG8_WAIT_V(8); PG8_WAIT_L(0); PG8_BAR; PG8_MMA(0, 0, At, B0); PG8_MMA(0, 1, At, B1); PG8_BAR; PG8_SCHED;
            PG8_LDA(At, 0, 1); PG8_STAGE(PG8_SB(0, 0), b2, voffB); PG8_STAGE(PG8_SB(0, 1), b2 + hstep, voffB); PG8_STAGE(PG8_SA(0, 0), a2, voffA);
            PG8_WAIT_V(8); PG8_WAIT_L(0); PG8_BAR; PG8_MMA(1, 0, At, B0); PG8_MMA(1, 1, At, B1); PG8_BAR; PG8_SCHED;
            PG8_LDB(B0, 1, 0); PG8_LDB(B1, 1, 1); PG8_SCHED; PG8_LDA(At, 1, 0); PG8_STAGE(PG8_SA(0, 1), a2 + hstep, voffA);
            PG8_WAIT_V(8); PG8_WAIT_L(0); PG8_BAR; PG8_MMA(0, 0, At, B0); PG8_MMA(0, 1, At, B1); PG8_BAR; PG8_SCHED;
            PG8_LDA(At, 1, 1); PG8_STAGE(PG8_SB(1, 0), b3, voffB); PG8_STAGE(PG8_SB(1, 1), b3 + hstep, voffB); PG8_STAGE(PG8_SA(1, 0), a3, voffA);
            PG8_WAIT_V(8); PG8_WAIT_L(0); PG8_BAR; PG8_MMA(1, 0, At, B0); PG8_MMA(1, 1, At, B1); PG8_BAR; PG8_SCHED;
            } else {
            PG8_LDB(B0, 0, 0); PG8_SCHED; PG8_LDA(At, 0, 0); PG8_STAGE(PG8_SA(1, 1), a1 + hstep, voffA);
            PG8_WAIT_L(8); PG8_BAR; PG8_WAIT_L(0); PG8_MMA(0, 0, At, B0); PG8_BAR; PG8_SCHED;
            PG8_LDB(B1, 0, 1); PG8_STAGE(PG8_SB(0, 0), b2, voffB);
            PG8_BAR; PG8_WAIT_L(0); PG8_MMA(0, 1, At, B1); PG8_BAR;
            PG8_LDA(At, 0, 1); PG8_STAGE(PG8_SA(0, 0), a2, voffA);
            PG8_BAR; PG8_WAIT_L(0); PG8_MMA(1, 0, At, B0); PG8_BAR; PG8_SCHED;
            PG8_STAGE(PG8_SB(0, 1), b2 + hstep, voffB);
            PG8_WAIT_V(6); PG8_BAR; PG8_MMA(1, 1, At, B1); PG8_BAR;
            PG8_LDB(B0, 1, 0); PG8_SCHED; PG8_LDA(At, 1, 0); PG8_STAGE(PG8_SA(0, 1), a2 + hstep, voffA);
            PG8_WAIT_L(8); PG8_BAR; PG8_WAIT_L(0); PG8_MMA(0, 0, At, B0); PG8_BAR; PG8_SCHED;
            PG8_LDB(B1, 1, 1); PG8_STAGE(PG8_SB(1, 0), b3, voffB);
            PG8_BAR; PG8_WAIT_L(0); PG8_MMA(0, 1, At, B1); PG8_BAR;
            PG8_LDA(At, 1, 1); PG8_STAGE(PG8_SA(1, 0), a3, voffA);
            PG8_BAR; PG8_WAIT_L(0); PG8_MMA(1, 0, At, B0); PG8_BAR; PG8_SCHED;
            PG8_STAGE(PG8_SB(1, 1), b3 + hstep, voffB);
            PG8_WAIT_V(6); PG8_BAR; PG8_MMA(1, 1, At, B1); PG8_BAR;
            }
        }
        if constexpr (ALIGN_EPI) { if (wr == 0) PG8_BAR; }
        if constexpr (!Epi::AFTER_DRAIN) { E(acc, cur, wr, wc, fr, fq); S.done(cur); }
        if (!has_next) break;
#pragma unroll
        for (int a = 0; a < 2; ++a)
#pragma unroll
            for (int b = 0; b < 2; ++b)
#pragma unroll
                for (int m = 0; m < 4; ++m)
#pragma unroll
                    for (int n = 0; n < 2; ++n) acc[a][b][m][n] = (f32x4){0.f, 0.f, 0.f, 0.f};
        cur = nxt; cA = nA; cB = nB; ++ui;
        if constexpr (ALIGN_EPI) { if (wr == 1) PG8_BAR; }
    }
    PG8_WAIT_V(0);
    if constexpr (!ALIGN_EPI) { if (wr == 0) PG8_BAR; }
    PG8_BAR;
    if constexpr (Epi::AFTER_DRAIN) { E.fused(acc, cur, wr, wc, fr, fq, lds, wid, lane); S.done(cur); }
#undef PG8_SA
#undef PG8_SB
#undef PG8_STAGE
#undef PG8_LDA
#undef PG8_LDB
#undef PG8_MMA
#undef PG8_WAIT_V
#undef PG8_WAIT_L
#undef PG8_BAR
#undef PG8_SCHED
}
}
namespace attn_body {
using bf16=__hip_bfloat16;
using bf16x8=__attribute__((ext_vector_type(8)))short;
using s16x4=__attribute__((ext_vector_type(4)))short;
using f32x16=__attribute__((ext_vector_type(16)))float;
using u32x4=__attribute__((ext_vector_type(4)))unsigned;
constexpr int D=64,PITCH=2304,OPITCH=1024,RPBATCH=2304;
constexpr int NW=8,QBLK=32,QB=QBLK*NW,KVBLK=64;
constexpr int ATTN_UNIT_ROWS=QB;
__device__ __forceinline__ int crow(int r,int hi){return (r&3)+8*(r>>2)+4*hi;}
#define SBAR() __builtin_amdgcn_sched_barrier(0)
__device__ __forceinline__ void cmask(f32x16&p0,f32x16&p1,int jb,int qrel,int hi){
  const float NEG=-INFINITY; int kb=64*jb+4*hi;
  #pragma unroll
  for(int r=0;r<16;++r){int kv=kb+(r&3)+8*(r>>2); if(kv>qrel)p0[r]=NEG; if(kv+32>qrel)p1[r]=NEG;}
}

template<int CK> __device__ __forceinline__ float sel_ck(float val,int c0,float neg){ int tmp; asm volatile("v_add_u32_e32 %1, %3, %2\n\tv_cmp_gt_u32_e32 vcc, 16, %1\n\tv_cndmask_b32_e32 %0, %4, %0, vcc":"+v"(val),"=&v"(tmp):"v"(c0),"n"(CK),"v"(neg):"vcc"); return val;}
__device__ __forceinline__ void na_mask(f32x16&p0,f32x16&p1,int t,int kr0,int rq,int rs,int cq,int cs,int hi,int h,const float*tab){
  if(t<4)return;
  const float NEG=-INFINITY; const int kr=kr0+t-4;
  if(kr<rs||kr>=rs+8){
    #pragma unroll
    for(int r=0;r<16;++r){p0[r]=NEG;p1[r]=NEG;}
    return; }
  const float*brow=tab+(kr-rq+7)*32+15-cq+4*hi; const int c0=4*hi-cs;
  #define CKOF(r) (((r)&3)+8*((r)>>2))
  #define NA1(r) do{ const float b0=brow[CKOF(r)], b1=brow[CKOF(r)+32]; p0[r]=sel_ck<CKOF(r)>(p0[r]+b0,c0,NEG); p1[r]=sel_ck<CKOF(r)+32>(p1[r]+b1,c0,NEG); }while(0)
  NA1(0);NA1(1);NA1(2);NA1(3); asm volatile("":::"memory");
  NA1(4);NA1(5);NA1(6);NA1(7); asm volatile("":::"memory");
  NA1(8);NA1(9);NA1(10);NA1(11); asm volatile("":::"memory");
  NA1(12);NA1(13);NA1(14);NA1(15);
  #undef NA1
  #undef CKOF
}
constexpr int NSLOT=3, SLOTB=8192;
constexpr int LDS_K=0, LDS_V=NSLOT*SLOTB, LDS_WS=2*NSLOT*SLOTB, LDS_OST=LDS_WS+NW*64*4, LDS_BYTES=LDS_OST+NW*4096;
constexpr float C2=0.125f*1.4426950408889634f;
__device__ __forceinline__ void glds16(const void*gsrc,unsigned lds_dst){unsigned keep;
  asm volatile("s_mov_b32 %0, m0\n\ts_mov_b32 m0, %2\n\ts_nop 0\n\tglobal_load_lds_dwordx4 %1, off\n\ts_mov_b32 m0, %0":"=&s"(keep):"v"(gsrc),"s"(lds_dst):"memory");}
__device__ __forceinline__ void glds16s(const void*sbase,unsigned voff,unsigned lds_dst){unsigned keep;
  asm volatile("s_mov_b32 %0, m0\n\ts_mov_b32 m0, %3\n\ts_nop 0\n\tglobal_load_lds_dwordx4 %1, %2\n\ts_mov_b32 m0, %0":"=&s"(keep):"v"(voff),"s"(sbase),"s"(lds_dst):"memory");}
__device__ __forceinline__ float max3f(float a,float b,float c){float r;asm("v_max3_f32 %0, %1, %2, %3":"=v"(r):"v"(a),"v"(b),"v"(c));return r;}
__device__ __forceinline__ float max2f(float a,float b){float r;asm("v_max_f32_e32 %0, %1, %2":"=v"(r):"v"(a),"v"(b));return r;}
__device__ __forceinline__ float fadd_s(float a,float b){float r;asm("v_add_f32_e32 %0, %1, %2":"=v"(r):"v"(a),"v"(b));return r;}
__device__ __forceinline__ float fsub_s(float a,float b){float r;asm("v_sub_f32_e32 %0, %1, %2":"=v"(r):"v"(a),"v"(b));return r;}
typedef float f32x2_t __attribute__((ext_vector_type(2))); typedef __bf16 bf16x2_t __attribute__((ext_vector_type(2)));
__device__ __forceinline__ unsigned cvtpk_s(float lo,float hi){f32x2_t v={lo,hi};bf16x2_t b=__builtin_convertvector(v,bf16x2_t);return __builtin_bit_cast(unsigned,b);}
#define WAIT_BAR(N) asm volatile("s_waitcnt vmcnt(" #N ") lgkmcnt(0)\n\ts_barrier":::"memory")

__device__ __forceinline__ void qkt(f32x16&p0,f32x16&p1,const char*Kslot,const bf16x8*qr,const f32x16&negm,int r32,int hi){
  const char*kb=Kslot+hi*1024+r32*16;
  #pragma unroll
  for(int d0=0;d0<4;++d0){
    const bf16x8 b0=*reinterpret_cast<const bf16x8*>(kb+d0*2048);
    const bf16x8 b1=*reinterpret_cast<const bf16x8*>(kb+d0*2048+512);
    if(d0==0){p0=__builtin_amdgcn_mfma_f32_32x32x16_bf16(b0,qr[0],negm,0,0,0);p1=__builtin_amdgcn_mfma_f32_32x32x16_bf16(b1,qr[0],negm,0,0,0);}
    else{p0=__builtin_amdgcn_mfma_f32_32x32x16_bf16(b0,qr[d0],p0,0,0,0);p1=__builtin_amdgcn_mfma_f32_32x32x16_bf16(b1,qr[d0],p1,0,0,0);}}
}
typedef __attribute__((address_space(3))) const char* lds_cptr;
typedef short v4i16_t __attribute__((ext_vector_type(4)));
__device__ __forceinline__ void kload8(bf16x8*kf,lds_cptr kp){
  kf[0]=*(const __attribute__((address_space(3))) bf16x8*)(kp);      kf[1]=*(const __attribute__((address_space(3))) bf16x8*)(kp+512);
  kf[2]=*(const __attribute__((address_space(3))) bf16x8*)(kp+2048); kf[3]=*(const __attribute__((address_space(3))) bf16x8*)(kp+2560);
  kf[4]=*(const __attribute__((address_space(3))) bf16x8*)(kp+4096); kf[5]=*(const __attribute__((address_space(3))) bf16x8*)(kp+4608);
  kf[6]=*(const __attribute__((address_space(3))) bf16x8*)(kp+6144); kf[7]=*(const __attribute__((address_space(3))) bf16x8*)(kp+6656);
}
__device__ __forceinline__ void kload2(bf16x8*kf,lds_cptr kp,int j){ kf[2*j]=*(const __attribute__((address_space(3))) bf16x8*)(kp+j*2048); kf[2*j+1]=*(const __attribute__((address_space(3))) bf16x8*)(kp+j*2048+512); }
__device__ __forceinline__ s16x4 vtr(lds_cptr p){ return __builtin_bit_cast(s16x4,__builtin_amdgcn_ds_read_tr16_b64_v4i16((__attribute__((address_space(3))) v4i16_t*)p)); }
__device__ __forceinline__ float rowmax(const f32x16&p0,const f32x16&p1){
  float a=max3f(p0[0],p0[1],p1[0]),b=max3f(p0[2],p0[3],p1[1]);a=max3f(a,p1[2],p1[3]);
  #pragma unroll
  for(int r=4;r<16;r+=4){a=max3f(a,p0[r],p0[r+1]);b=max3f(b,p0[r+2],p0[r+3]);a=max3f(a,p1[r],p1[r+1]);b=max3f(b,p1[r+2],p1[r+3]);}
  const float m=max2f(a,b);
  auto rr=__builtin_amdgcn_permlane32_swap(__float_as_uint(m),__float_as_uint(m),false,false);
  return max2f(__uint_as_float(rr[0]),__uint_as_float(rr[1]));
}
__device__ __forceinline__ void pv(f32x16*o,int vb,bf16x8 pa0,bf16x8 pa1,bf16x8 pa2,bf16x8 pa3){
  #pragma unroll
  for(int d0=0;d0<2;++d0){s16x4 lo[4],hi[4];
    #pragma unroll
    for(int ks=0;ks<4;++ks){
      asm volatile("ds_read_b64_tr_b16 %0,%1 offset:%c2":"=&v"(lo[ks]):"v"(vb),"i"(d0*4096+ks*1024):"memory");
      asm volatile("ds_read_b64_tr_b16 %0,%1 offset:%c2":"=&v"(hi[ks]):"v"(vb),"i"(d0*4096+ks*1024+512):"memory");}
    asm volatile("s_waitcnt lgkmcnt(0)":::"memory");SBAR();
    #define PK(k) (bf16x8){lo[k][0],lo[k][1],lo[k][2],lo[k][3],hi[k][0],hi[k][1],hi[k][2],hi[k][3]}
    o[d0]=__builtin_amdgcn_mfma_f32_32x32x16_bf16(pa0,PK(0),o[d0],0,0,0);
    o[d0]=__builtin_amdgcn_mfma_f32_32x32x16_bf16(pa1,PK(1),o[d0],0,0,0);
    o[d0]=__builtin_amdgcn_mfma_f32_32x32x16_bf16(pa2,PK(2),o[d0],0,0,0);
    o[d0]=__builtin_amdgcn_mfma_f32_32x32x16_bf16(pa3,PK(3),o[d0],0,0,0);
    #undef PK
  }
}

#ifndef ATTN_STORE16
#define ATTN_STORE16(p,v) (*(u32x4*)(p)=(v))
#endif
template<int MODE,int THRL> __device__ __forceinline__ void attn_unit(int b,int q0,int qcol,int kcol,int vcol,int ocol,int tb,int NTin,int kr0,const float*rpbh,const bf16*QKV,bf16*O,char*shm){
  int tid_=threadIdx.x; asm volatile("":"+v"(tid_)); const int tid=tid_,lane=tid&63,r32=lane&31,hi=lane>>5; const int wid=__builtin_amdgcn_readfirstlane(tid>>6);
  const long rowbase=(long)b*RPBATCH;
  const bf16*Qw=QKV+(rowbase+q0+wid*QBLK)*PITCH+qcol;
  const bf16*Kh=QKV+rowbase*PITCH+kcol,*Vh=QKV+rowbase*PITCH+vcol;
  const unsigned lds0=(unsigned)(uintptr_t)shm;
  float*wsf=(float*)(shm+LDS_WS)+wid*64;
  const unsigned koff=(unsigned)(lane*PITCH+wid*8)*2u;
  const unsigned voffv=(unsigned)((16*(wid&3)+(lane>>2))*PITCH+(wid>>2)*32+(lane&3)*8)*2u;
  const unsigned kdst=lds0+LDS_K+wid*1024, vdst=lds0+LDS_V+wid*1024;
  #define TROW(t) ((MODE==1)?(((t)<4)?(2048+64*(t)):(64*(kr0+(t)-4))):(tb+64*(t)))
  #define DMA_K(t,slot) glds16s(Kh+(long)TROW(t)*PITCH,koff,(unsigned)__builtin_amdgcn_readfirstlane(kdst+(slot)))
  #define DMA_V(t,slot) glds16s(Vh+(long)TROW(t)*PITCH,voffv,(unsigned)__builtin_amdgcn_readfirstlane(vdst+(slot)))
  const int vb0=(int)(lds0+LDS_V)+((lane>>4)&1)*32+(lane&3)*8+(4*hi+((lane&15)>>2))*64;
  const char*Kbase=shm+LDS_K; bf16x8 kf[8];
  const lds_cptr shm3=(lds_cptr)shm; const lds_cptr kp0=shm3+LDS_K+hi*1024+r32*16; const lds_cptr vp0=shm3+LDS_V+((lane>>4)&1)*32+(lane&3)*8+(4*hi+((lane&15)>>2))*64;
  const int NT=(MODE==1)?16:NTin;
  const int rq=(q0>>6)+(wid>>1), cq=(wid&1)*32+r32; const int rs=min(max(rq-4,0),24), cs=min(max(cq-8,0),48);
  float*tab=(float*)(shm+LDS_BYTES);
  if(MODE==1){ for(int i=tid;i<15*32;i+=NW*64){const int ii=i>>5,jj=i&31; tab[i]=(jj<31)?rpbh[ii*31+jj]*1.4426950408889634f:0.f;} }
  DMA_K(0,0);DMA_V(0,0);DMA_K(1,SLOTB);
  bf16x8 qr[4];
  #pragma unroll
  for(int d0=0;d0<4;++d0)qr[d0]=*reinterpret_cast<const bf16x8*>(&Qw[(long)r32*PITCH+d0*16+hi*8]);
  float mhat=0.f,l_reg=0.f;f32x16 o[2];o[0]=f32x16{};o[1]=f32x16{};const f32x16 negm=f32x16{};
  const int qrel=wid*QBLK+r32;
  #define CMASK(P0,P1,t) do{ if(MODE==1) na_mask(P0,P1,(t),kr0,rq,rs,cq,cs,hi,wid&1,tab); }while(0)
  bool resc=false;
  #define START(P0,P1) do{ const float rm=rowmax(P0,P1); resc=false; \
    { const float dl=rm; mhat=fadd_s(mhat,dl); \
      _Pragma("unroll") for(int r=0;r<16;++r){P0[r]=fsub_s(P0[r],dl);P1[r]=fsub_s(P1[r],dl);} \
      } \
    _Pragma("unroll") for(int r=0;r<16;++r)P0[r]=__builtin_amdgcn_exp2f(P0[r]); }while(0)
  #define RESC() do{ if(resc){ asm volatile("s_waitcnt lgkmcnt(0)":::"memory"); \
      _Pragma("unroll") for(int d_=0;d_<2;++d_) _Pragma("unroll") for(int r=0;r<16;++r)o[d_][r]*=wsf[crow(r,hi)]; } }while(0)
  f32x16 pA0,pA1,pB0,pB1;
  int sl_prev=0,sl_cur=0,sl_next=SLOTB;
  #define ROT() do{sl_prev=sl_cur;sl_cur=sl_next;sl_next=(sl_next==(NSLOT-1)*SLOTB)?0:sl_next+SLOTB;}while(0)
  DMA_K(2,2*SLOTB);
  WAIT_BAR(3);
  qkt(pA0,pA1,Kbase,qr,negm,r32,hi);asm volatile("s_nop 15\n\ts_nop 7":"+v"(pA0),"+v"(pA1));CMASK(pA0,pA1,0);
  START(pA0,pA1);
  _Pragma("unroll") for(int r=0;r<16;++r)pA1[r]=__builtin_amdgcn_exp2f(pA1[r]);
  WAIT_BAR(0);
  DMA_K(3,0);DMA_V(1,SLOTB);
  ROT();
  kload8(kf,kp0+sl_cur);
  WAIT_BAR(2);
  s16x4 vlo[8],vhi[8]; u32x4 pw0,pw1,pw2,pw3;
  #define PKW(P,B) cvtpk_s(P[B],P[B+1])
  #define PAF(k) __builtin_bit_cast(bf16x8,pw##k)
  #define VFR(i) (bf16x8){vlo[i][0],vlo[i][1],vlo[i][2],vlo[i][3],vhi[i][0],vhi[i][1],vhi[i][2],vhi[i][3]}
  #define PIN(x) asm volatile("":"+v"(x))
  #define MX3(a,b,c) __builtin_fmaxf(__builtin_fmaxf((a),(b)),(c))
  #define GAPA(MF,A0,A1,A2,A3,W0,W1,PW) do{ MF; sacc+=A0; sacc+=A1; sacc+=A2; sacc+=A3; PIN(sacc); W0; W1; PIN(PW); SBAR(); }while(0)
  #define EX(v) __builtin_amdgcn_exp2f(v)
  #define GAPB(MF,X,B) do{ MF; X[B]=EX(X[B]); X[B+1]=EX(X[B+1]); X[B+2]=EX(X[B+2]); X[B+3]=EX(X[B+3]); PIN(X); SBAR(); }while(0)
  #define VRD(i) do{ vlo[i]=vtr(vp_+(((i)>>2)*4096+((i)&3)*1024)); vhi[i]=vtr(vp_+(((i)>>2)*4096+((i)&3)*1024+512)); }while(0)
  #define KRD(G,j) do{ if(G){ kload2(kf,kp0+sl_next,j); SBAR(); } }while(0)
  #define STEP(C0,C1,P0,P1,t,GK,GV,GL) do{ SBAR(); \
    const lds_cptr vp_=vp0+sl_prev; \
    VRD(0); SBAR(); float sacc=(P0[0]+P0[1]); \
    GAPA(C0=__builtin_amdgcn_mfma_f32_32x32x16_bf16(kf[0],qr[0],negm,0,0,0), P0[2],P0[3],P0[4],P0[5],     pw0[0]=PKW(P0,0), pw0[1]=PKW(P0,2), pw0); \
    VRD(4); SBAR(); GAPA(C1=__builtin_amdgcn_mfma_f32_32x32x16_bf16(kf[1],qr[0],negm,0,0,0), P0[6],P0[7],P0[8],P0[9],     pw0[2]=PKW(P0,4), pw0[3]=PKW(P0,6), pw0); \
    VRD(1); SBAR(); GAPA(C0=__builtin_amdgcn_mfma_f32_32x32x16_bf16(kf[2],qr[1],C0,0,0,0),   P0[10],P0[11],P0[12],P0[13], pw1[0]=PKW(P0,8), pw1[1]=PKW(P0,10), pw1); \
    VRD(5); SBAR(); GAPA(C1=__builtin_amdgcn_mfma_f32_32x32x16_bf16(kf[3],qr[1],C1,0,0,0),   P0[14],P0[15],P1[0],P1[1],   pw1[2]=PKW(P0,12),pw1[3]=PKW(P0,14), pw1); \
    VRD(2); SBAR(); GAPA(C0=__builtin_amdgcn_mfma_f32_32x32x16_bf16(kf[4],qr[2],C0,0,0,0),   P1[2],P1[3],P1[4],P1[5],     pw2[0]=PKW(P1,0), pw2[1]=PKW(P1,2), pw2); \
    VRD(6); SBAR(); GAPA(C1=__builtin_amdgcn_mfma_f32_32x32x16_bf16(kf[5],qr[2],C1,0,0,0),   P1[6],P1[7],P1[8],P1[9],     pw2[2]=PKW(P1,4), pw2[3]=PKW(P1,6), pw2); \
    VRD(3); SBAR(); GAPA(C0=__builtin_amdgcn_mfma_f32_32x32x16_bf16(kf[6],qr[3],C0,0,0,0),   P1[10],P1[11],P1[12],P1[13], pw3[0]=PKW(P1,8), pw3[1]=PKW(P1,10), pw3); \
    VRD(7); SBAR(); GAPA(C1=__builtin_amdgcn_mfma_f32_32x32x16_bf16(kf[7],qr[3],C1,0,0,0),   P1[14],P1[15],0.f,0.f,       pw3[2]=PKW(P1,12),pw3[3]=PKW(P1,14), pw3); \
    l_reg+=sacc; \
    if(GK){DMA_K((t)+3,sl_cur);} if(GV){DMA_V((t)+1,sl_next);} \
    _Pragma("unroll") for(int r=0;r<16;++r){C0[r]-=mhat;C1[r]-=mhat;} \
    CMASK(C0,C1,t); \
    { float a=MX3(C0[0],C0[1],C1[0]),b=MX3(C0[2],C0[3],C1[1]); a=MX3(a,C1[2],C1[3]); \
      _Pragma("unroll") for(int r=4;r<16;r+=4){a=MX3(a,C0[r],C0[r+1]);b=MX3(b,C0[r+2],C0[r+3]);a=MX3(a,C1[r],C1[r+1]);b=MX3(b,C1[r+2],C1[r+3]);} \
      float rm=__builtin_fmaxf(a,b); { auto rr=__builtin_amdgcn_permlane32_swap(__float_as_uint(rm),__float_as_uint(rm),false,false); rm=__builtin_fmaxf(__uint_as_float(rr[0]),__uint_as_float(rr[1])); } \
      resc=false; \
      if(__builtin_expect(__any(rm>(float)THRL),0)){ const float dl=__builtin_fmaxf(rm,0.f); mhat+=dl; \
        _Pragma("unroll") for(int r=0;r<16;++r){C0[r]-=dl;C1[r]-=dl;} \
        const float f=__builtin_amdgcn_exp2f(-dl); l_reg*=f; if(hi==0)wsf[r32]=f; resc=true; } } \
    SBAR(); \
    GAPB(o[0]=__builtin_amdgcn_mfma_f32_32x32x16_bf16(PAF(0),VFR(0),o[0],0,0,0), C0,0); \
    GAPB(o[1]=__builtin_amdgcn_mfma_f32_32x32x16_bf16(PAF(0),VFR(4),o[1],0,0,0), C0,4); \
    KRD(GL,0); GAPB(o[0]=__builtin_amdgcn_mfma_f32_32x32x16_bf16(PAF(1),VFR(1),o[0],0,0,0), C0,8); \
    KRD(GL,1); GAPB(o[1]=__builtin_amdgcn_mfma_f32_32x32x16_bf16(PAF(1),VFR(5),o[1],0,0,0), C0,12); \
    KRD(GL,2); GAPB(o[0]=__builtin_amdgcn_mfma_f32_32x32x16_bf16(PAF(2),VFR(2),o[0],0,0,0), C1,0); \
    KRD(GL,3); GAPB(o[1]=__builtin_amdgcn_mfma_f32_32x32x16_bf16(PAF(2),VFR(6),o[1],0,0,0), C1,4); \
    GAPB(o[0]=__builtin_amdgcn_mfma_f32_32x32x16_bf16(PAF(3),VFR(3),o[0],0,0,0), C1,8); \
    GAPB(o[1]=__builtin_amdgcn_mfma_f32_32x32x16_bf16(PAF(3),VFR(7),o[1],0,0,0), C1,12); \
    }while(0)
  int t=1;
  _Pragma("nounroll") for(;t+5<NT;t+=2){
    STEP(pB0,pB1,pA0,pA1,t,true,true,true);     WAIT_BAR(2); RESC(); ROT();
    STEP(pA0,pA1,pB0,pB1,t+1,true,true,true);   WAIT_BAR(2); RESC(); ROT();
  }
  #define ENDW(tt) do{ if((tt)+3<NT){WAIT_BAR(2);} else if((tt)+2<NT){WAIT_BAR(1);} else {WAIT_BAR(0);} }while(0)
  _Pragma("nounroll") for(;t+1<NT;t+=2){
    STEP(pB0,pB1,pA0,pA1,t,(t+3<NT),(t+1<NT),(t+1<NT));       ENDW(t);   RESC(); ROT();
    STEP(pA0,pA1,pB0,pB1,t+1,(t+4<NT),(t+2<NT),(t+2<NT));     ENDW(t+1); RESC(); ROT();
  }
  STEP(pB0,pB1,pA0,pA1,NT-1,false,false,false); RESC();
  { float sacc=pB0[0]+pB0[1]; _Pragma("unroll") for(int r=2;r<16;++r)sacc+=pB0[r]; _Pragma("unroll") for(int r=0;r<16;++r)sacc+=pB1[r]; l_reg+=sacc;
    pw0=(u32x4){PKW(pB0,0),PKW(pB0,2),PKW(pB0,4),PKW(pB0,6)};pw1=(u32x4){PKW(pB0,8),PKW(pB0,10),PKW(pB0,12),PKW(pB0,14)};pw2=(u32x4){PKW(pB1,0),PKW(pB1,2),PKW(pB1,4),PKW(pB1,6)};pw3=(u32x4){PKW(pB1,8),PKW(pB1,10),PKW(pB1,12),PKW(pB1,14)};
    SBAR(); pv(o,vb0+sl_cur,PAF(0),PAF(1),PAF(2),PAF(3)); }
  #undef PKW
  #undef PAF
  #undef VFR
  #undef PIN
  #undef MX3
  #undef GAPA
  #undef GAPB
  #undef EX
  #undef VRD
  #undef KRD
  #undef STEP
  #undef ENDW
  {auto rr=__builtin_amdgcn_permlane32_swap(__float_as_uint(l_reg),__float_as_uint(l_reg),false,false);l_reg=__uint_as_float(rr[0])+__uint_as_float(rr[1]);}
  if(hi==0)wsf[32+r32]=l_reg;asm volatile("s_waitcnt lgkmcnt(0)":::"memory");
  float rli[16];
  #pragma unroll
  for(int r=0;r<16;++r)rli[r]=__builtin_amdgcn_rcpf(wsf[32+crow(r,hi)]);
  bf16*Ow=O+(rowbase+q0+wid*QBLK)*OPITCH+ocol;
  { bf16*stg=(bf16*)(shm+LDS_OST)+wid*2048;
    #pragma unroll
    for(int r=0;r<16;++r){const int orow=crow(r,hi);
      #pragma unroll
      for(int d0=0;d0<2;++d0)stg[orow*64+d0*32+r32]=__float2bfloat16(o[d0][r]*rli[r]);}
    asm volatile("s_waitcnt lgkmcnt(0)":::"memory");
    #pragma unroll
    for(int i=0;i<4;++i){const int row=i*8+(lane>>3),ch=lane&7; const u32x4 v=*(const u32x4*)(stg+row*64+ch*8); ATTN_STORE16(Ow+(long)row*OPITCH+ch*8,v);} }
  asm volatile("s_waitcnt lgkmcnt(0)\n\ts_barrier":::"memory");
  #undef DMA_K
  #undef TROW
  #undef DMA_V
  #undef CMASK
  #undef START
  #undef RESC
  #undef ROT
}
constexpr int ATTN_LDS_BYTES=LDS_BYTES+2048;
#undef SBAR
#undef WAIT_BAR
}
constexpr int NWAVES = 8;
constexpr int DMODEL = 1024, NBATCH = 8, SEQL = 2048, CTXL = 256, RPB = SEQL + CTXL  , MROWS = NBATCH * RPB  ;
constexpr int DFF = 2816, N13 = 2 * DFF, NIN = 2304, NMOD = 9, MODW = NMOD * DMODEL;
constexpr float EPS = 1e-6f;
constexpr float QC2 = 0.125f * 1.4426950408889634f;
constexpr size_t MiB = 1u << 20;
constexpr size_t WS_CTL = 0, CTL_ZERO_BYTES = 1 * MiB;
constexpr size_t WS_MODS = 1 * MiB;
constexpr size_t WS_ROPE = 2 * MiB;
constexpr size_t WS_W = 3 * MiB;
constexpr size_t SZ_W13 = (size_t)N13 * DMODEL * 2, SZ_W2 = (size_t)DMODEL * DFF * 2, SZ_WIN = (size_t)NIN * DMODEL * 2, SZ_WOUT = (size_t)DMODEL * DMODEL * 2;
constexpr size_t OFF_W13A = 0, OFF_W2A = OFF_W13A + SZ_W13, OFF_WIN = OFF_W2A + SZ_W2, OFF_WOUT = OFF_WIN + SZ_WIN, OFF_W13B = OFF_WOUT + SZ_WOUT, OFF_W2B = OFF_W13B + SZ_W13, SZ_WLAYER = OFF_W2B + SZ_W2;
constexpr size_t WS_XS = WS_W + 2 * SZ_WLAYER;
constexpr size_t WS_U = WS_XS + (size_t)MROWS * DMODEL * 4;
constexpr size_t WS_O = WS_U + (size_t)MROWS * DFF * 2;
constexpr size_t WS_END = WS_O + (size_t)MROWS * DMODEL * 2;
static_assert(WS_O == WS_O_BYTES && WS_END == WS_END_BYTES && WS_U == WS_U_BYTES, "slab offsets");
static_assert(WS_XS % 256 == 0 && WS_U % 256 == 0 && WS_O % 256 == 0, "alignment");
constexpr int CW_BAR = 4096;
constexpr int RING_BYTES = 131072, LDSCTL_OFF = RING_BYTES, MISC_OFF = LDSCTL_OFF + 320, LDS_BYTES = 147456, ROPE_LDS_OFF = RING_BYTES + 2048;
static_assert(ROPE_LDS_OFF + 8192 <= LDS_BYTES && MISC_OFF + 128 <= ROPE_LDS_OFF, "LDS map");

#define GAS __attribute__((address_space(1)))
#define LAS __attribute__((address_space(3)))
typedef unsigned short bf16;
typedef unsigned v4u __attribute__((ext_vector_type(4)));
typedef unsigned v2u __attribute__((ext_vector_type(2)));
typedef float f32x4 __attribute__((ext_vector_type(4)));
typedef float f32x2 __attribute__((ext_vector_type(2)));
#define LDS_WAIT() asm volatile("s_waitcnt lgkmcnt(0)" ::: "memory")
__device__ __forceinline__ unsigned f2bf(float f) { unsigned u = __builtin_bit_cast(unsigned, f); return (u + 0x7fffu + ((u >> 16) & 1u)) >> 16; }
__device__ __forceinline__ unsigned pk2(float lo, float hi) { return f2bf(lo) | (f2bf(hi) << 16); }
__device__ __forceinline__ float bf2f(unsigned short h) { return __builtin_bit_cast(float, (unsigned)h << 16); }
__device__ __forceinline__ float wave_sum(float v) {
#pragma unroll
    for (int o = 1; o < 64; o <<= 1) v += __shfl_xor(v, o);
    return v;
}
#define RLX_AGENT __ATOMIC_RELAXED, __HIP_MEMORY_SCOPE_AGENT
#define XB_TMO      128
#define XB_XCNT(j)  (256  + 64 * (j))
#define XB_XSUB(j)  (1280 + 64 * (j))
#define XB_XGEN(j)  (2304 + 64 * (j))
#define XB_TOP      3328
#define XB_TOPGEN   3392
#define XCD_BAR_WORDS 3456
#define XB_SPIN_CAP (1u << 18)

__device__ __forceinline__ unsigned xb_ld(unsigned* p)              { return __hip_atomic_load(p, __ATOMIC_RELAXED, __HIP_MEMORY_SCOPE_AGENT); }
__device__ __forceinline__ unsigned xb_add(unsigned* p, unsigned v) { return __hip_atomic_fetch_add(p, v, __ATOMIC_RELAXED, __HIP_MEMORY_SCOPE_AGENT); }
__device__ __forceinline__ unsigned xb_xcc_id() { return (unsigned)__builtin_amdgcn_s_getreg((3 << 11) | 20) & 0xFu; }
#define XB_SPIN(cond, bar) do { unsigned _sp = 0; while (cond) { __builtin_amdgcn_s_sleep(1); \
    if ((++_sp & 255u) == 0u) { if (xb_ld(&(bar)[XB_TMO])) break; if (_sp > XB_SPIN_CAP) { atomicAdd(&(bar)[XB_TMO], 1u); break; } } } } while (0)

struct XcdBarrier {
    unsigned* bar; unsigned x;
    volatile LAS unsigned* st;
};

__device__ __forceinline__ XcdBarrier xcd_barrier_post(unsigned* bar, volatile LAS unsigned* st) {
    XcdBarrier b; b.bar = bar; b.x = xb_xcc_id(); b.st = st;
    if (threadIdx.x == 0) (void)xb_add(&bar[XB_XCNT(b.x)], 1u);
    return b;
}
__device__ __forceinline__ void xcd_barrier_complete(unsigned* bar, unsigned x, unsigned& nloc, unsigned& nx) {
    const unsigned G = gridDim.x * gridDim.y * gridDim.z;
    unsigned sum, cnt, mine, sp = 0u;
    for (;;) {
        sum = 0u; cnt = 0u; mine = 0u;
#pragma unroll
        for (unsigned j = 0; j < 16; ++j) { const unsigned c = xb_ld(&bar[XB_XCNT(j)]); sum += c; cnt += (c > 0u) ? 1u : 0u; mine = (j == x) ? c : mine; }
        if (sum == G) break;
        __builtin_amdgcn_s_sleep(1);
        if ((++sp & 255u) == 0u) { if (xb_ld(&bar[XB_TMO])) break; if (sp > XB_SPIN_CAP) { atomicAdd(&bar[XB_TMO], 1u); break; } }
    }
    nloc = mine > 0u ? mine : 1u; nx = cnt > 0u ? cnt : 1u;
}

__device__ __forceinline__ void xcd_barrier(const XcdBarrier& b) {
    asm volatile("s_waitcnt vmcnt(0)" ::: "memory");
    __syncthreads();
    if (threadIdx.x == 0) {
        unsigned* bar = b.bar;
        __builtin_amdgcn_s_waitcnt(0);
        unsigned nloc = b.st[0], nx = b.st[1];
        if (nloc == 0u) { xcd_barrier_complete(bar, b.x, nloc, nx); b.st[0] = nloc; b.st[1] = nx; }
        const unsigned old = xb_add(&bar[XB_XSUB(b.x)], 1u);
        const unsigned gen = old / nloc;
        if (old + 1u == (gen + 1u) * nloc) {
            __builtin_amdgcn_fence(__ATOMIC_RELEASE, "agent");
            asm volatile("s_waitcnt vmcnt(0)" ::: "memory");
            const unsigned og = xb_add(&bar[XB_TOP], 1u);
            const unsigned tg = og / nx;
            if (og + 1u == (tg + 1u) * nx) xb_add(&bar[XB_TOPGEN], 1u);
            else XB_SPIN(xb_ld(&bar[XB_TOPGEN]) == tg, bar);
            __builtin_amdgcn_fence(__ATOMIC_ACQUIRE, "agent");
            xb_add(&bar[XB_XGEN(b.x)], 1u);
            asm volatile("s_waitcnt vmcnt(0)" ::: "memory");
        } else {
            XB_SPIN(xb_ld(&bar[XB_XGEN(b.x)]) == gen, bar);
            __builtin_amdgcn_fence(__ATOMIC_ACQUIRE, "agent");
            asm volatile("s_waitcnt vmcnt(0)" ::: "memory");
        }
    }
    __syncthreads();
}
struct Args {
    const float* in[21]; float* out; unsigned char* ws; int pad0, pad1;
};
typedef const __attribute__((address_space(4))) Args* ArgsP;
__device__ __forceinline__ ArgsP get_args() { ArgsP p = (ArgsP)__builtin_amdgcn_kernarg_segment_ptr(); asm volatile("" : "+s"(p)); return p; }
struct Frame {
    LAS unsigned char* lds; int tid, lane, wave, vcu, G;
    __device__ __forceinline__ void refresh() { int t = threadIdx.x; asm volatile("" : "+v"(t)); tid = t; lane = t & 63; wave = __builtin_amdgcn_readfirstlane(t >> 6); }
};
template <int MAP> __device__ __forceinline__ int map_dest(int s) {
    if (MAP == 1) { const int bj = s >= DFF ? 1 : 0, r = s - bj * DFF; return (r >> 7) * 256 + bj * 128 + (r & 127); }
    if (MAP == 2) { const int pn = s >> 8, rem = s & 255, wc = rem >> 6, bj = (rem >> 5) & 1, x = rem & 31, hh = pn * 4 + wc;
        if (hh >= 24 && hh < 34) { const int nn = (x >> 4) & 1, fq = (x >> 2) & 3, e = x & 3; return pn * 256 + bj * 128 + wc * 32 + fq * 8 + nn * 4 + e; }
        return pn * 256 + bj * 128 + wc * 32 + x; }
    return s;
}
template <int MAP> __device__ __forceinline__ void p0_transpose_item(const float* W, int K, int N, bf16* WT, LAS float* scr, int item, int lane) {
    const int nblk = N / 32, kb = item / nblk, nb = item % nblk, k0 = 64 * kb, n0 = 32 * nb;
#pragma unroll 8
    for (int i = 0; i < 32; ++i) { const int kk = 2 * i + (lane >> 5); scr[kk * 33 + (lane & 31)] = W[(size_t)(k0 + kk) * N + n0 + (lane & 31)]; }
    LDS_WAIT(); asm volatile("" ::: "memory");
    const int c = lane & 7;
#pragma unroll
    for (int j = 0; j < 4; ++j) { const int n = (lane >> 3) + 8 * j; const LAS float* s = scr + (8 * c) * 33 + n;
        v4u o; o.x = pk2(s[0 * 33], s[1 * 33]); o.y = pk2(s[2 * 33], s[3 * 33]); o.z = pk2(s[4 * 33], s[5 * 33]); o.w = pk2(s[6 * 33], s[7 * 33]);
        *(GAS v4u*)(WT + (size_t)map_dest<MAP>(n0 + n) * K + k0 + 8 * c) = o; }
    LDS_WAIT(); asm volatile("" ::: "memory");
}
__device__ __forceinline__ void p0_mod_unit(const Frame& F, int unit, const float* c, const float* cctx, const float* wmod, const float* bmod, float* mods) {
    const int layer = unit / 72, col0 = (unit % 72) * 128;
    LAS float* sc = (LAS float*)F.lds;
    LAS float* red = sc + 9 * 1024;
    for (int i = F.tid; i < 9 * 1024; i += NWAVES * 64) { const int j = i >> 10, k = i & 1023; const float v = j < 8 ? c[j * 1024 + k] : cctx[k]; sc[i] = v / (1.0f + expf(-v)); }
    __syncthreads();
    const float* W = wmod + (size_t)layer * 1024 * MODW + col0 + 2 * F.lane;
    float a0[9], a1[9];
#pragma unroll
    for (int j = 0; j < 9; ++j) { a0[j] = 0.f; a1[j] = 0.f; }
    const int kw = F.wave * 128;
    for (int kk = 0; kk < 128; kk += 8) {
        f32x2 w[8];
#pragma unroll
        for (int q = 0; q < 8; ++q) w[q] = *(const f32x2*)(W + (size_t)(kw + kk + q) * MODW);
#pragma unroll
        for (int q = 0; q < 8; ++q)
#pragma unroll
            for (int j = 0; j < 9; ++j) { const float s = sc[j * 1024 + kw + kk + q]; a0[j] += s * w[q].x; a1[j] += s * w[q].y; }
    }
#pragma unroll
    for (int j = 0; j < 9; ++j) { red[(F.wave * 9 + j) * 128 + 2 * F.lane] = a0[j]; red[(F.wave * 9 + j) * 128 + 2 * F.lane + 1] = a1[j]; }
    __syncthreads();
    for (int i = F.tid; i < 9 * 128; i += NWAVES * 64) { const int j = i >> 7, cc = i & 127; float s = 0.f;
#pragma unroll
        for (int w = 0; w < 8; ++w) s += red[(w * 9 + j) * 128 + cc];
        mods[(size_t)(layer * 9 + j) * MODW + col0 + cc] = s + bmod[layer * MODW + col0 + cc]; }
    __syncthreads();
}
__device__ __forceinline__ void p0_prologue(Frame F, ArgsP A) {
    F.refresh();
    unsigned char* ws = A->ws;
    if ((int)blockIdx.x < 144) p0_mod_unit(F, (int)blockIdx.x, A->in[1], A->in[3], A->in[4], A->in[5], (float*)(ws + WS_MODS));
    if ((int)blockIdx.x == F.G - 1) {
        float* rc = (float*)(ws + WS_ROPE); float* rs = rc + 1024;
        for (int i = F.tid; i < 1024; i += NWAVES * 64) { const int pos = i >> 4, fi = i & 15; const float inv = powf(10000.0f, -(float)(2 * fi) / 32.0f); const float ang = (float)pos * inv; rc[i] = cosf(ang); rs[i] = sinf(ang); }
    }
    LAS float* scr = (LAS float*)(F.lds + F.wave * 16384);
    const int gw = F.vcu * NWAVES + F.wave, NGW = F.G * NWAVES;
    constexpr int I13 = (DMODEL / 64) * (N13 / 32), I2 = (DFF / 64) * (DMODEL / 32), IIN = (DMODEL / 64) * (NIN / 32), IOUT = (DMODEL / 64) * (DMODEL / 32);
    constexpr int ILAYER = 2 * I13 + 2 * I2 + IIN + IOUT;
    for (int it = gw; it < 2 * ILAYER; it += NGW) {
        const int l = it / ILAYER; int r = it % ILAYER;
        unsigned char* wl = ws + WS_W + (size_t)l * SZ_WLAYER;
        if (r < I13) { p0_transpose_item<1>(A->in[7] + (size_t)l * DMODEL * N13, DMODEL, N13, (bf16*)(wl + OFF_W13A), scr, r, F.lane); continue; } r -= I13;
        if (r < I13) { p0_transpose_item<1>(A->in[18] + (size_t)l * DMODEL * N13, DMODEL, N13, (bf16*)(wl + OFF_W13B), scr, r, F.lane); continue; } r -= I13;
        if (r < I2) { p0_transpose_item<0>(A->in[8] + (size_t)l * DFF * DMODEL, DFF, DMODEL, (bf16*)(wl + OFF_W2A), scr, r, F.lane); continue; } r -= I2;
        if (r < I2) { p0_transpose_item<0>(A->in[19] + (size_t)l * DFF * DMODEL, DFF, DMODEL, (bf16*)(wl + OFF_W2B), scr, r, F.lane); continue; } r -= I2;
        if (r < IIN) { p0_transpose_item<2>(A->in[10] + (size_t)l * DMODEL * NIN, DMODEL, NIN, (bf16*)(wl + OFF_WIN), scr, r, F.lane); continue; } r -= IIN;
        p0_transpose_item<0>(A->in[16] + (size_t)l * DMODEL * DMODEL, DMODEL, DMODEL, (bf16*)(wl + OFF_WOUT), scr, r, F.lane);
    }
}
__device__ __forceinline__ void modnorm_phase(Frame F, ArgsP A, bool first, bool latent_only, int combine  , const float* g, const float* modl  , int chunk_shift) {
    F.refresh();
    float* xs = (float*)(A->ws + WS_XS); bf16* H = (bf16*)A->out;
    const int gw = F.vcu * NWAVES + F.wave, NGW = F.G * NWAVES;
    for (int row = gw; row < MROWS; row += NGW) {
        const int b = row / RPB, t = row - b * RPB; const bool isctx = t >= SEQL; const int j = isctx ? 8 : b;
        if (isctx && latent_only) continue;
        const float* src = first ? (isctx ? A->in[2] + (size_t)(b * CTXL + t - SEQL) * DMODEL : A->in[0] + (size_t)(b * SEQL + t) * DMODEL) : xs + (size_t)row * DMODEL;
        const GAS f32x4* xr = (const GAS f32x4*)src + F.lane;
        f32x4 v[4]; float s2 = 0.f;
#pragma unroll
        for (int q = 0; q < 4; ++q) { v[q] = xr[64 * q]; s2 += (v[q].x * v[q].x + v[q].y * v[q].y) + (v[q].z * v[q].z + v[q].w * v[q].w); }
        if (combine && row >= 16384) {
#pragma unroll
            for (int ch = 0; ch < 8; ++ch) { const GAS f32x4* pr = (const GAS f32x4*)(pg8::part_slab(A->ws, (unsigned char*)A->out, ch, combine == 2) + (size_t)(row - 16384) * DMODEL) + F.lane;
#pragma unroll
                for (int q = 0; q < 4; ++q) v[q] = v[q] + pr[64 * q]; }
            s2 = 0.f; GAS f32x4* xo = (GAS f32x4*)(xs + (size_t)row * DMODEL) + F.lane;
#pragma unroll
            for (int q = 0; q < 4; ++q) { xo[64 * q] = v[q]; s2 += (v[q].x * v[q].x + v[q].y * v[q].y) + (v[q].z * v[q].z + v[q].w * v[q].w); }
        }
        const float rstd = 1.0f / sqrtf(wave_sum(s2) * (1.0f / DMODEL) + EPS);
        const float* sh = modl + (size_t)j * MODW + chunk_shift * DMODEL; const float* scl = sh + DMODEL;
        if (first) { GAS f32x4* xo = (GAS f32x4*)(xs + (size_t)row * DMODEL) + F.lane;
#pragma unroll
            for (int q = 0; q < 4; ++q) xo[64 * q] = v[q]; }
        GAS unsigned long long* o8 = (GAS unsigned long long*)(H + (size_t)row * DMODEL) + F.lane;
#pragma unroll
        for (int q = 0; q < 4; ++q) { const int col = 4 * F.lane + 256 * q;
            const f32x4 gg = *(const f32x4*)(g + col), sc = *(const f32x4*)(scl + col), sf = *(const f32x4*)(sh + col);
            const f32x4 h = v[q] * rstd * gg * (sc + 1.0f) + sf;
            o8[64 * q] = (unsigned long long)pk2(h.x, h.y) | ((unsigned long long)pk2(h.z, h.w) << 32); }
    }
}
__device__ __forceinline__ void onorm_phase(Frame F, ArgsP A, bool latent_only, const float* ga, const float* gb) {
    F.refresh();
    bf16* O = (bf16*)(A->ws + WS_O);
    const int gw = F.vcu * NWAVES + F.wave, NGW = F.G * NWAVES;
    for (int row = gw; row < MROWS; row += NGW) {
        const int t = row % RPB; if (t >= SEQL && latent_only) continue;
        GAS v4u* p = (GAS v4u*)(O + (size_t)row * DMODEL) + F.lane;
        v4u wa = p[0], wb = p[64]; float xa[8], xb[8]; float sa = 0.f, sb = 0.f;
#pragma unroll
        for (int q = 0; q < 4; ++q) { xa[2 * q] = __builtin_bit_cast(float, wa[q] << 16); xa[2 * q + 1] = __builtin_bit_cast(float, wa[q] & 0xffff0000u);
            xb[2 * q] = __builtin_bit_cast(float, wb[q] << 16); xb[2 * q + 1] = __builtin_bit_cast(float, wb[q] & 0xffff0000u); }
#pragma unroll
        for (int q = 0; q < 8; ++q) { sa += xa[q] * xa[q]; sb += xb[q] * xb[q]; }
        const float ra = 1.0f / sqrtf(wave_sum(sa) * (1.0f / 512.0f) + EPS), rb = 1.0f / sqrtf(wave_sum(sb) * (1.0f / 512.0f) + EPS);
        const f32x4 a0 = *(const f32x4*)(ga + 8 * F.lane), a1 = *(const f32x4*)(ga + 8 * F.lane + 4), b0 = *(const f32x4*)(gb + 8 * F.lane), b1 = *(const f32x4*)(gb + 8 * F.lane + 4);
        v4u oa, ob;
        oa.x = pk2(xa[0] * ra * a0.x, xa[1] * ra * a0.y); oa.y = pk2(xa[2] * ra * a0.z, xa[3] * ra * a0.w); oa.z = pk2(xa[4] * ra * a1.x, xa[5] * ra * a1.y); oa.w = pk2(xa[6] * ra * a1.z, xa[7] * ra * a1.w);
        ob.x = pk2(xb[0] * rb * b0.x, xb[1] * rb * b0.y); ob.y = pk2(xb[2] * rb * b0.z, xb[3] * rb * b0.w); ob.z = pk2(xb[4] * rb * b1.x, xb[5] * rb * b1.y); ob.w = pk2(xb[6] * rb * b1.z, xb[7] * rb * b1.w);
        p[0] = oa; p[64] = ob;
    }
}
__device__ __forceinline__ void final_phase(Frame F, ArgsP A) {
    F.refresh();
    const float* xs = (const float*)(A->ws + WS_XS); const float* g = A->in[20];
    const int gw = F.vcu * NWAVES + F.wave, NGW = F.G * NWAVES;
    for (int r = gw; r < NBATCH * SEQL; r += NGW) {
        const int b = r / SEQL, t = r - b * SEQL;
        const GAS f32x4* xr = (const GAS f32x4*)(xs + (size_t)(b * RPB + t) * DMODEL) + F.lane;
        f32x4 v[4]; float s2 = 0.f;
#pragma unroll
        for (int q = 0; q < 4; ++q) { v[q] = xr[64 * q]; s2 += (v[q].x * v[q].x + v[q].y * v[q].y) + (v[q].z * v[q].z + v[q].w * v[q].w); }
        const float rstd = 1.0f / sqrtf(wave_sum(s2) * (1.0f / DMODEL) + EPS);
        GAS f32x4* o = (GAS f32x4*)(A->out + (size_t)r * DMODEL) + F.lane;
#pragma unroll
        for (int q = 0; q < 4; ++q) o[64 * q] = v[q] * rstd * *(const f32x4*)(g + 4 * F.lane + 256 * q);
    }
}
__device__ __forceinline__ void attn_phase(const Frame& F, ArgsP A, int layer, bool do_ctx, char* lds) {
    const attn_body::bf16* QKV = (const attn_body::bf16*)(A->ws + WS_U); attn_body::bf16* O = (attn_body::bf16*)(A->ws + WS_O);
    const float* rpb = A->in[11] + (size_t)layer * 8 * 15 * 31;
#ifndef NO_MODE0
    {
        const int per = (512 + F.G - 1) / F.G, perc = do_ctx ? (128 + F.G - 1) / F.G : 0;
        for (int i = 0; i < per + perc; ++i) {
            int b, q0, qcol, kcol, vcol, ocol, tb, nt;
            if (i < per) { const int u = per * F.vcu + i; if (u >= 512) continue; const int qb = u & 7, hq = (u >> 3) & 7, kvh = hq >> 2; b = u >> 6; q0 = qb * 256; qcol = 1536 + hq * 64; kcol = 2048 + kvh * 64; vcol = 2176 + kvh * 64; ocol = 512 + hq * 64; tb = 0; nt = 36; }
            else { const int uc = perc * F.vcu + (i - per); if (uc >= 128) continue; const int v = uc & 63, h = v & 7; b = v >> 3; q0 = 2048; tb = 2048; nt = 4;
                if (uc < 64) { qcol = 1536 + h * 64; kcol = 2048 + (h >> 2) * 64; vcol = 2176 + (h >> 2) * 64; ocol = 512 + h * 64; }
                else { qcol = h * 64; kcol = 512 + h * 64; vcol = 1024 + h * 64; ocol = h * 64; } }
            attn_body::attn_unit<0, 8>(b, q0, qcol, kcol, vcol, ocol, tb, nt, 0, nullptr, QKV, O, lds);
        }
    }
#endif
#ifndef NO_MODE1
    for (int i = 0; i < (512 + F.G - 1) / F.G; ++i) {
        const int u = ((512 + F.G - 1) / F.G) * F.vcu + i; if (u >= 512) continue; const int qb = u & 7, h = (u >> 3) & 7, b = u >> 6;
        const int kr0 = min(max(4 * qb - 4, 0), 20);
        attn_body::attn_unit<1, 8>(b, qb * 256, h * 64, 512 + h * 64, 1024 + h * 64, h * 64, 0, 16, kr0, rpb + h * 15 * 31, QKV, O, lds);
    }
#endif
}

__global__ void __launch_bounds__(NWAVES * 64, 2) fwd_megakernel(Args A_unused_directly) {
    extern __shared__ __attribute__((aligned(16))) unsigned char lds[];
    cg::grid_group grid = cg::this_grid();
    Frame F;
    F.lds = (LAS unsigned char*)lds;
    F.refresh();
    F.G = gridDim.x; { const int bx = blockIdx.x; F.vcu = (F.G % 8 == 0) ? (bx % 8) * (F.G / 8) + bx / 8 : bx; }
    for (int u = F.tid; u < (LDS_BYTES - LDSCTL_OFF) / 4; u += NWAVES * 64) ((LAS unsigned*)(F.lds + LDSCTL_OFF))[u] = 0u;
    __syncthreads();
    XcdBarrier bar = xcd_barrier_post((unsigned*)(get_args()->ws + WS_CTL) + CW_BAR, (volatile LAS unsigned*)(F.lds + MISC_OFF) + 8);
#ifdef ALL_CG_SYNC
#define GRID_BAR() grid.sync()
#else
#define GRID_BAR() xcd_barrier(bar)
#endif

    p0_prologue(F, get_args());
#ifdef PROBE_P0X2
    __syncthreads(); p0_prologue(F, A);
#endif
    grid.sync();
    for (int l = 0; l < 2; ++l) {
        const bool last = (l == 1);
#define MODL(A_) ((const float*)((A_)->ws + WS_MODS) + (size_t)l * 9 * MODW)
#define WL(A_) ((A_)->ws + WS_W + (size_t)l * SZ_WLAYER)
        for (int f = 0; f < 2; ++f) {
            const bool lat = last && f == 1;
            { ArgsP A = get_args(); modnorm_phase(F, A, l == 0 && f == 0, lat, (l == 1 && f == 0) ? 1 : ((l == 0 && f == 1) ? 2 : 0)  , (f == 0 ? A->in[6] : A->in[17]) + l * DMODEL, MODL(A), f == 0 ? 0 : 6); }
#ifdef PROBE_NORMX2
            if (f == 1) { GRID_BAR(); ArgsP A = get_args(); modnorm_phase(F, A, false, lat, false, A->in[17] + l * DMODEL, MODL(A), 6); }
#endif
            GRID_BAR();
            {
                ArgsP A = get_args(); unsigned char* ws = A->ws; unsigned char* wl = WL(A);
                pg8::Gemm g{(const pg8::bf16_t*)A->out, (const pg8::bf16_t*)(wl + (f == 0 ? OFF_W13A : OFF_W13B)), MROWS, N13, DMODEL};
                pg8::Sched2 S; S.init(N13, DMODEL, F.G, (int)blockIdx.x, lat, false);
                pg8::EpiSwiglu E{(pg8::bf16_t*)(ws + WS_U), DFF};
#ifndef NO_G1
                pg8::gemm_phase<pg8::EpiSwiglu, pg8::Sched2, true, true>(F.lds, g, S, E);
#endif
#ifdef PROBE_G1X2
                GRID_BAR(); pg8::gemm_phase<pg8::EpiSwiglu, pg8::Sched2, true, true>(F.lds, g, S, E);
#endif
            }
            GRID_BAR();
            {
                ArgsP A = get_args(); unsigned char* ws = A->ws; unsigned char* wl = WL(A); const float* modl = MODL(A);
                pg8::Gemm g{(const pg8::bf16_t*)(ws + WS_U), (const pg8::bf16_t*)(wl + (f == 0 ? OFF_W2A : OFF_W2B)), MROWS, DMODEL, DFF};
                pg8::Sched2 S; S.init(DMODEL, DFF, F.G, (int)blockIdx.x, lat, true);
                pg8::EpiResid E{(float*)(ws + WS_XS), modl + (f == 0 ? 2 : 8) * DMODEL, 0.5f, ws, (unsigned char*)A->out, 0};
#ifndef NO_G2
                pg8::gemm_phase<pg8::EpiResid, pg8::Sched2, true, true>(F.lds, g, S, E);
#endif
#ifdef PROBE_G2X3
                if (!(l == 1 && f == 1)) { GRID_BAR(); E.s = -0.5f; S.cpu = 0; S.full = S.nwg; pg8::gemm_phase<pg8::EpiResid, pg8::Sched2, true, true>(F.lds, g, S, E);
                GRID_BAR(); E.s = 0.5f; pg8::gemm_phase<pg8::EpiResid, pg8::Sched2, true, true>(F.lds, g, S, E); }
#endif
            }
            GRID_BAR();
            if (f == 0) {
                { ArgsP A = get_args(); modnorm_phase(F, A, false, false, 1  , A->in[9] + l * DMODEL, MODL(A), 3); }
                GRID_BAR();
                {
                    ArgsP A = get_args(); unsigned char* ws = A->ws; unsigned char* wl = WL(A); const float* rc = (const float*)(ws + WS_ROPE); const float* rs = rc + 1024;
                    pg8::Gemm g{(const pg8::bf16_t*)A->out, (const pg8::bf16_t*)(wl + OFF_WIN), MROWS, NIN, DMODEL};
                    pg8::Sched2 S; S.init(NIN, DMODEL, F.G, (int)blockIdx.x, false, false);
                    LAS float* ropel = (LAS float*)(F.lds + ROPE_LDS_OFF);
                    for (int i = threadIdx.x; i < 2048; i += NWAVES * 64) ropel[i] = rc[i];
                    __syncthreads();
                    pg8::EpiQkv E{(pg8::bf16_t*)(ws + WS_U), A->in[12] + l * 64, A->in[13] + l * 64, ropel, ropel + 1024, QC2, EPS};
#ifndef NO_GIN
                    pg8::gemm_phase<pg8::EpiQkv, pg8::Sched2, true, true>(F.lds, g, S, E);
#endif
#ifdef PROBE_GINX2
                    GRID_BAR(); pg8::gemm_phase<pg8::EpiQkv, pg8::Sched2, true, true>(F.lds, g, S, E);
#endif
                }
                GRID_BAR();
#ifndef NO_ATTN
                attn_phase(F, get_args(), l, !last, (char*)lds);
#endif
#ifdef PROBE_ATTNX2
                GRID_BAR(); attn_phase(F, get_args(), l, !last, (char*)lds);
#endif
                GRID_BAR();
                { ArgsP A = get_args(); onorm_phase(F, A, last, A->in[14] + l * 512, A->in[15] + l * 512); }
                GRID_BAR();
                {
                    ArgsP A = get_args(); unsigned char* ws = A->ws; unsigned char* wl = WL(A); const float* modl = MODL(A);
                    pg8::Gemm g{(const pg8::bf16_t*)(ws + WS_O), (const pg8::bf16_t*)(wl + OFF_WOUT), MROWS, DMODEL, DMODEL};
                    pg8::Sched2 S; S.init(DMODEL, DMODEL, F.G, (int)blockIdx.x, last, true);
                    pg8::EpiResid E{(float*)(ws + WS_XS), modl + 5 * DMODEL, 1.0f, ws, (unsigned char*)A->out, 1};
#ifndef NO_GOUT
                    pg8::gemm_phase<pg8::EpiResid, pg8::Sched2, true, true>(F.lds, g, S, E);
#endif
                }
                GRID_BAR();
            }
        }
    }
    final_phase(F, get_args());
}

extern "C" void kernel_launch(void* const* d_in, const int* in_sizes, int n_in, void* d_out, int out_size, void* d_ws, size_t ws_size, hipStream_t stream) {
    static int grid = 0;
    if (grid == 0) {
        if (n_in != 21 || out_size != NBATCH * SEQL * DMODEL || ws_size < WS_END + pg8::SLAB_BYTES) { fprintf(stderr, "kernel_launch: unexpected shapes (n_in %d, out %d, ws %zu, need %zu)\n", n_in, out_size, ws_size, (size_t)WS_END); grid = -1; return; }
        int dev = 0, cus = 0, per_cu = 0;
        if (hipGetDevice(&dev) != hipSuccess || hipDeviceGetAttribute(&cus, hipDeviceAttributeMultiprocessorCount, dev) != hipSuccess) { grid = -1; return; }
        if (hipFuncSetAttribute((const void*)fwd_megakernel, hipFuncAttributeMaxDynamicSharedMemorySize, LDS_BYTES) != hipSuccess) { fprintf(stderr, "kernel_launch: hipFuncSetAttribute failed\n"); grid = -1; return; }
        if (hipOccupancyMaxActiveBlocksPerMultiprocessor(&per_cu, (const void*)fwd_megakernel, NWAVES * 64, LDS_BYTES) != hipSuccess || per_cu < 1) { fprintf(stderr, "kernel_launch: occupancy query says %d blocks per CU\n", per_cu); (void)hipGetLastError(); grid = -1; return; }
        grid = cus;
    }
    if (grid < 0) return;
    (void)hipMemsetAsync((char*)d_ws + WS_CTL, 0, CTL_ZERO_BYTES, stream);
    Args a{};
    for (int i = 0; i < 21; ++i) a.in[i] = (const float*)d_in[i];
    a.out = (float*)d_out; a.ws = (unsigned char*)d_ws;
    void* args[] = {&a};
    hipError_t e = hipLaunchCooperativeKernel((const void*)fwd_megakernel, dim3(grid), dim3(NWAVES * 64), args, LDS_BYTES, stream);
    if (e != hipSuccess) fprintf(stderr, "kernel_launch: cooperative launch failed: %s (grid %d)\n", hipGetErrorString(e), grid);
}
```

```cpp
#include <hip/hip_runtime.h>
#include <hip/hip_bf16.h>
#include <hip/hip_cooperative_groups.h>
#include <cstdio>
#include <cstdint>
#include <cmath>
namespace cg = cooperative_groups;
#define WS_O_BYTES 265289728ull
#define WS_END_BYTES 303038464ull
#define WS_U_BYTES 161480704ull
namespace pg8 {
#define PG8_LAS __attribute__((address_space(3)))
typedef unsigned short bf16_t;
typedef short bf16x8 __attribute__((ext_vector_type(8)));
typedef float f32x4 __attribute__((ext_vector_type(4)));
typedef unsigned u32x4 __attribute__((ext_vector_type(4)));
constexpr int BM = 256, BK = 64, HALF = 128, HTB = HALF * BK * 2  , STAGE_BYTES = 8 * HTB, NXCD = 8, WGM = 8;

__host__ __device__ __forceinline__ int lds_byte(int r, int c) { const int st = (r >> 4) * 2 + (c >> 5), rr = r & 15, cc = c & 31, ob = rr * 64 + cc * 2; return st * 1024 + (ob ^ (((ob >> 9) & 1) << 5)); }
__host__ __device__ __forceinline__ void stage_rc(int b, int& R, int& C) { const int st = b / 1024, sb = b % 1024, swz = sb ^ (((sb >> 9) & 1) << 5); R = (st >> 1) * 16 + swz / 64; C = (st & 1) * 32 + (swz % 64) / 2; }
__host__ __device__ __forceinline__ int perm32(int rho) { const int n = rho >> 4, i = rho & 15; return 8 * (i >> 2) + 4 * n + (i & 3); }

struct Unit { int pm, pn, k0, nk, ch, part; };
struct Gemm { const bf16_t* A; const bf16_t* Bt; int M, N, K; };

struct StaticOrder {
    int nM, nN, nwg, G, c;
    __host__ __device__ void init(int M, int N, int G_, int c_) { nM = M / BM; nN = N / BM; nwg = nM * nN; G = G_; c = c_; }
    __host__ __device__ bool next(int i, Unit& u) const {
        const long L = (long)i * G + c; if (L >= nwg) return false;
        int wgid = (int)L; { const int q = nwg / NXCD, r = nwg % NXCD, xcd = wgid % NXCD, off = wgid / NXCD; wgid = (xcd < r ? xcd * (q + 1) : r * (q + 1) + (xcd - r) * q) + off; }
        const int nig = WGM * nN, gid = wgid / nig, fm = gid * WGM, gsz = (nM - fm) < WGM ? (nM - fm) : WGM;
        u.pm = fm + ((wgid % nig) % gsz); u.pn = (wgid % nig) / gsz; u.k0 = 0; u.nk = 0; u.ch = 0; u.part = 0; return true;
    }
    __device__ __forceinline__ void a_ready(const Unit&) const {}
    __device__ __forceinline__ void done(const Unit&) const {}
};

__device__ __forceinline__ unsigned cvt_pk_bf16(float lo, float hi) { unsigned r; asm volatile("v_cvt_pk_bf16_f32 %0, %1, %2" : "=v"(r) : "v"(lo), "v"(hi)); return r; }
typedef float f32x2 __attribute__((ext_vector_type(2)));
typedef unsigned u32x2 __attribute__((ext_vector_type(2)));
constexpr size_t SLAB_BYTES = (size_t)2048 * 1024 * 4, SLAB_WS_O = (size_t)WS_O_BYTES, SLAB_WS_END = (size_t)WS_END_BYTES, SLAB_OUT = (size_t)36 << 20;
__device__ __forceinline__ float* part_slab(unsigned char* ws, unsigned char* outb, int ch, int sel) {
    if (sel) return (float*)(ws + WS_U_BYTES + (size_t)ch * SLAB_BYTES);
    return (float*)(ch < 4 ? ws + SLAB_WS_O + (size_t)ch * SLAB_BYTES : (ch == 4 ? ws + SLAB_WS_END : outb + SLAB_OUT + (size_t)(ch - 5) * SLAB_BYTES));
}
struct EpiSwiglu {
    static constexpr bool PERM = true, AFTER_DRAIN = false;
    bf16_t* U; int ldu;
    __device__ __forceinline__ void operator()(const f32x4 (&acc)[2][2][4][2], const Unit& u, int wr, int wc, int fr, int fq) const {
        const int row0 = u.pm * BM + wr * 64 + fr, col0 = u.pn * HALF + wc * 32 + 8 * fq;
#pragma unroll
        for (int ai = 0; ai < 2; ++ai)
#pragma unroll
            for (int m = 0; m < 4; ++m) {
                float r[8];
#pragma unroll
                for (int n = 0; n < 2; ++n)
#pragma unroll
                    for (int e = 0; e < 4; ++e) { const float a = acc[ai][0][m][n][e], g = acc[ai][1][m][n][e];
                        r[n * 4 + e] = a * g * __builtin_amdgcn_rcpf(1.0f + __builtin_amdgcn_exp2f(-1.4426950408889634f * g)); }
                u32x4 w; w.x = cvt_pk_bf16(r[0], r[1]); w.y = cvt_pk_bf16(r[2], r[3]); w.z = cvt_pk_bf16(r[4], r[5]); w.w = cvt_pk_bf16(r[6], r[7]);
                *(u32x4*)(U + (size_t)(row0 + ai * HALF + m * 16) * ldu + col0) = w; }
    }
};
struct EpiResid {
    static constexpr bool PERM = false, AFTER_DRAIN = false;
    float* X; const float* gate; float s;
    unsigned char* ws; unsigned char* outb; int sel;
    __device__ __forceinline__ void operator()(const f32x4 (&acc)[2][2][4][2], const Unit& u, int wr, int wc, int fr, int fq) const {
        const int j = (u.pm % 9 == 8) ? 8 : u.pm / 9;
        const int row0 = u.pm * BM + wr * 64 + fr, col0 = u.pn * BM + wc * 32 + 4 * fq;
        const float* gp = gate + (size_t)j * 9216 + col0;
        float* slab = u.part ? part_slab(ws, outb, u.ch, sel) - (size_t)16384 * 1024 : X;
        f32x4 gv[2][2];
#pragma unroll
        for (int bj = 0; bj < 2; ++bj)
#pragma unroll
            for (int n = 0; n < 2; ++n) gv[bj][n] = *(const f32x4*)(gp + bj * HALF + n * 16) * s;
#pragma unroll
        for (int ai = 0; ai < 2; ++ai)
#pragma unroll
            for (int m = 0; m < 4; ++m) { float* rowp = X + (size_t)(row0 + ai * HALF + m * 16) * 1024 + col0;
#pragma unroll
                for (int bj = 0; bj < 2; ++bj)
#pragma unroll
                    for (int n = 0; n < 2; ++n) { float* pf = rowp + bj * HALF + n * 16; const f32x4 d = gv[bj][n] * acc[ai][bj][m][n];
                        if (u.part) *(f32x4*)(slab + (pf - X)) = d;
                        else { f32x4* p = (f32x4*)pf; *p = *p + d; } }
                if (m & 1) asm volatile("" ::: "memory"); }
    }
};
struct EpiQkv {
    static constexpr bool PERM = true, AFTER_DRAIN = false;
    bf16_t* QKV; const float* qn; const float* kn; const PG8_LAS float* rc; const PG8_LAS float* rs; float c2; float eps;
    __device__ __forceinline__ void operator()(const f32x4 (&acc)[2][2][4][2], const Unit& u, int wr, int wc, int fr, int fq) const {
        const int hh = u.pn * 4 + wc;
        const bool isq = (hh < 8) || (hh >= 24 && hh < 32), nrm = (hh >= 24 && hh < 34);
        const float* gn = (hh < 32) ? qn : kn;
        const int tq = u.pm % 9; const bool latent = tq != 8; const int tbase = tq * 256;
        f32x4 gv[2][2];
#pragma unroll
        for (int bj = 0; bj < 2; ++bj)
#pragma unroll
            for (int n = 0; n < 2; ++n) gv[bj][n] = nrm ? *(const f32x4*)(gn + 32 * bj + 16 * n + 4 * fq) : (f32x4){1.f, 1.f, 1.f, 1.f};
        const float osc = isq ? c2 : 1.0f;
#pragma unroll
        for (int ai = 0; ai < 2; ++ai)
#pragma unroll
            for (int m = 0; m < 4; ++m) {
                const int rit = ai * HALF + wr * 64 + m * 16 + fr; const size_t row = (size_t)u.pm * BM + rit;
                f32x4 v[2][2];
#pragma unroll
                for (int bj = 0; bj < 2; ++bj)
#pragma unroll
                    for (int n = 0; n < 2; ++n) v[bj][n] = acc[ai][bj][m][n];
                if (nrm) {
                    float ss = 0.f;
#pragma unroll
                    for (int bj = 0; bj < 2; ++bj)
#pragma unroll
                        for (int n = 0; n < 2; ++n) ss += (v[bj][n][0] * v[bj][n][0] + v[bj][n][1] * v[bj][n][1]) + (v[bj][n][2] * v[bj][n][2] + v[bj][n][3] * v[bj][n][3]);
                    ss += __shfl_xor(ss, 16); ss += __shfl_xor(ss, 32);
                    const float r = 1.0f / sqrtf(ss * (1.0f / 64.0f) + eps);
#pragma unroll
                    for (int bj = 0; bj < 2; ++bj)
#pragma unroll
                        for (int n = 0; n < 2; ++n) v[bj][n] = v[bj][n] * r * gv[bj][n];
                    if (latent) {
                        const int t = tbase + rit, pr = t >> 6, pc = t & 63;
#pragma unroll
                        for (int bj = 0; bj < 2; ++bj) { const int pos = bj ? pc : pr;
                            const f32x4 co = *(const PG8_LAS f32x4*)(rc + pos * 16 + 4 * fq), si = *(const PG8_LAS f32x4*)(rs + pos * 16 + 4 * fq);
                            const f32x4 x1 = v[bj][0], x2 = v[bj][1];
                            v[bj][0] = x1 * co - x2 * si; v[bj][1] = x2 * co + x1 * si; }
                    }
                }
                if (nrm) {
                    bf16_t* op = QKV + row * 2304 + hh * 64 + 4 * fq;
#pragma unroll
                    for (int bj = 0; bj < 2; ++bj)
#pragma unroll
                        for (int n = 0; n < 2; ++n) { const f32x4 o = v[bj][n] * osc; u32x2 w; w.x = cvt_pk_bf16(o[0], o[1]); w.y = cvt_pk_bf16(o[2], o[3]); *(u32x2*)(op + 32 * bj + 16 * n) = w; }
                } else {
                    bf16_t* op = QKV + row * 2304 + hh * 64 + 8 * fq;
#pragma unroll
                    for (int bj = 0; bj < 2; ++bj) { const f32x4 o0 = v[bj][0] * osc, o1 = v[bj][1] * osc; u32x4 w; w.x = cvt_pk_bf16(o0[0], o0[1]); w.y = cvt_pk_bf16(o0[2], o0[3]); w.z = cvt_pk_bf16(o1[0], o1[1]); w.w = cvt_pk_bf16(o1[2], o1[3]); *(u32x4*)(op + 32 * bj) = w; }
                }
                asm volatile("" ::: "memory");
            }
    }
};
struct Sched2 {
    int nM, nN, nwg, G, c, nt, full, cpu; bool skip;
    __device__ __forceinline__ void init(int N, int K, int G_, int c_, bool latent_only, bool split) {
        nM = latent_only ? 64 : 72; nN = N / BM; nwg = nM * nN; G = G_; c = c_; nt = K / BK; skip = latent_only; full = nwg; cpu = 0;
        if (split) { const int rem = nwg % G; if (rem == 32 && nwg == 288 && G == 256 && (nt / 2) >= G / rem)   { full = nwg - rem; cpu = G / rem; } }
    }
    __device__ __forceinline__ bool next(int i, Unit& u) const {
        const int L = i * G + c;
        int wgid, k0 = 0, nk = nt, ch = 0, part = 0;
        if (L < full) { wgid = L; const int q = full / NXCD, r = full % NXCD, xcd = wgid % NXCD, off = wgid / NXCD; wgid = (xcd < r ? xcd * (q + 1) : r * (q + 1) + (xcd - r) * q) + off; }
        else if (cpu && L < full + G) { const int j = L - full; ch = j % cpu; wgid = full + j / cpu;
            const int pairs = nt / 2, base = pairs / cpu, ext = pairs % cpu; k0 = 2 * (ch * base + (ch < ext ? ch : ext)); nk = 2 * (base + (ch < ext ? 1 : 0)); part = 1; }
        else return false;
        const int nig = WGM * nN, gid = wgid / nig, fm = gid * WGM, gsz = (nM - fm) < WGM ? (nM - fm) : WGM;
        int pm = fm + ((wgid % nig) % gsz); const int pn = (wgid % nig) / gsz;
        if (skip) pm += pm >> 3;
        u.pm = pm; u.pn = pn; u.k0 = k0; u.nk = nk; u.ch = ch; u.part = part;
        return true;
    }
    __device__ __forceinline__ void a_ready(const Unit&) const {}
    __device__ __forceinline__ void done(const Unit&) const {}
};
template <class Epi, class Sched, bool ALIGN_EPI = false, bool SP2 = false>
__device__ __forceinline__ void gemm_phase(PG8_LAS unsigned char* lds, const Gemm g, const Sched& S, const Epi& E) {
    int tid_ = threadIdx.x; asm volatile("" : "+v"(tid_));
    const int tid = tid_, wid = __builtin_amdgcn_readfirstlane(tid >> 6), lane = tid & 63, wr = wid >> 2, wc = wid & 3, fr = lane & 15, fq = lane >> 4;
    const int K = g.K;
    unsigned voffA[2], voffB[2];
#pragma unroll
    for (int i = 0; i < 2; ++i) { int R, C; stage_rc(tid * 16 + i * 8192, R, C); const int Rb = Epi::PERM ? ((R & ~31) + perm32(R & 31)) : R;
        voffA[i] = (unsigned)(R * K + C) * 2u; voffB[i] = (unsigned)(Rb * K + C) * 2u; }
    const size_t kstep = (size_t)(BK * 2);
    const size_t hstep = (size_t)HALF * K * 2;
    const size_t tstep = 2 * hstep;
    const unsigned ldsw = (unsigned)wid * 1024u;
    const int aoff = lds_byte(wr * 64 + fr, fq * 8), boff = lds_byte(wc * 32 + fr, fq * 8);
#define PG8_SA(b, h) (((b) * 2 + (h)) * HTB)
#define PG8_SB(b, h) ((4 + (b) * 2 + (h)) * HTB)
#define PG8_STAGE(bufoff, gbase, voff) do { _Pragma("unroll") for (int _i = 0; _i < 2; ++_i) \
        __builtin_amdgcn_global_load_lds((const unsigned*)((const char*)(gbase) + (voff)[_i]), (PG8_LAS unsigned*)(lds + (bufoff) + ldsw + _i * 8192), 16, 0, 0); } while (0)
#define PG8_LDA(dst, b, h) do { _Pragma("unroll") for (int m = 0; m < 4; ++m) _Pragma("unroll") for (int k = 0; k < 2; ++k) dst[m][k] = *(const PG8_LAS bf16x8*)(lds + PG8_SA(b, h) + aoff + m * 2048 + k * 1024); } while (0)
#define PG8_LDB(dst, b, h) do { _Pragma("unroll") for (int n = 0; n < 2; ++n) _Pragma("unroll") for (int k = 0; k < 2; ++k) dst[n][k] = *(const PG8_LAS bf16x8*)(lds + PG8_SB(b, h) + boff + n * 2048 + k * 1024); } while (0)
#define PG8_MMA(ai, bj, At, Bt) do { __builtin_amdgcn_s_setprio(1); _Pragma("unroll") for (int m = 0; m < 4; ++m) _Pragma("unroll") for (int n = 0; n < 2; ++n) _Pragma("unroll") for (int k = 0; k < 2; ++k) \
        acc[ai][bj][m][n] = __builtin_amdgcn_mfma_f32_16x16x32_bf16(Bt[n][k], At[m][k], acc[ai][bj][m][n], 0, 0, 0); __builtin_amdgcn_s_setprio(0); } while (0)
#define PG8_WAIT_V(n) asm volatile("s_waitcnt vmcnt(" #n ")" ::: "memory")
#define PG8_WAIT_L(n) asm volatile("s_waitcnt lgkmcnt(" #n ")" ::: "memory")
#define PG8_BAR __builtin_amdgcn_s_barrier()
#define PG8_SCHED __builtin_amdgcn_sched_barrier(0)
    Unit cur, nxt; int ui = 0;
    if (!S.next(0, cur)) return;
    f32x4 acc[2][2][4][2];
#pragma unroll
    for (int a = 0; a < 2; ++a)
#pragma unroll
        for (int b = 0; b < 2; ++b)
#pragma unroll
            for (int m = 0; m < 4; ++m)
#pragma unroll
                for (int n = 0; n < 2; ++n) acc[a][b][m][n] = (f32x4){0.f, 0.f, 0.f, 0.f};
    bf16x8 At[4][2], B0[2][2], B1[2][2];
    const char* cA = (const char*)g.A + (size_t)cur.pm * tstep + (size_t)cur.k0 * kstep; const char* cB = (const char*)g.Bt + (size_t)cur.pn * tstep + (size_t)cur.k0 * kstep;
    S.a_ready(cur);
    if constexpr (SP2) {
        PG8_STAGE(PG8_SB(0, 0), cB, voffB); PG8_STAGE(PG8_SB(0, 1), cB + hstep, voffB); PG8_STAGE(PG8_SA(0, 0), cA, voffA); PG8_STAGE(PG8_SA(0, 1), cA + hstep, voffA);
        if (wr == 1) PG8_BAR;
        PG8_WAIT_V(2); PG8_BAR;
        PG8_STAGE(PG8_SB(1, 0), cB + kstep, voffB); PG8_STAGE(PG8_SA(1, 0), cA + kstep, voffA); PG8_STAGE(PG8_SB(1, 1), cB + hstep + kstep, voffB);
        PG8_WAIT_V(6); PG8_BAR;
    } else {
        PG8_STAGE(PG8_SB(0, 0), cB, voffB); PG8_STAGE(PG8_SA(0, 0), cA, voffA); PG8_STAGE(PG8_SB(0, 1), cB + hstep, voffB); PG8_STAGE(PG8_SA(0, 1), cA + hstep, voffA);
        if (wr == 1) PG8_BAR;
        PG8_WAIT_V(4); PG8_BAR;
        PG8_STAGE(PG8_SB(1, 0), cB + kstep, voffB); PG8_STAGE(PG8_SA(1, 0), cA + kstep, voffA); PG8_STAGE(PG8_SB(1, 1), cB + hstep + kstep, voffB);
        PG8_WAIT_V(6); PG8_BAR;
    }
    for (;;) {
        const bool has_next = S.next(ui + 1, nxt);
        const char* nA = has_next ? (const char*)g.A + (size_t)nxt.pm * tstep + (size_t)nxt.k0 * kstep : cA; const char* nB = has_next ? (const char*)g.Bt + (size_t)nxt.pn * tstep + (size_t)nxt.k0 * kstep : cB;
        const int nt = cur.nk;
        for (int t = 0; t < nt; t += 2) {
            const bool last = (t == nt - 2);
            const char* a1 = cA + (size_t)(t + 1) * kstep;
            const char* a2 = last ? nA : cA + (size_t)(t + 2) * kstep; const char* b2 = last ? nB : cB + (size_t)(t + 2) * kstep;
            const char* a3 = a2 + kstep; const char* b3 = b2 + kstep;
            if (last && has_next) S.a_ready(nxt);
            if constexpr (SP2) {
            PG8_LDB(B0, 0, 0); PG8_LDB(B1, 0, 1); PG8_SCHED; PG8_LDA(At, 0, 0); PG8_STAGE(PG8_SA(1, 1), a1 + hstep, voffA);
            PG8_WAIT_V(8); PG8_WAIT_L(0); PG8_BAR; PG8_MMA(0, 0, At, B0); PG8_MMA(0, 1, At, B1); PG8_BAR; PG8_SCHED;
            PG8_LDA(At, 0, 1); PG8_STAGE(PG8_SB(0, 0), b2, voffB); PG8_STAGE(PG8_SB(0, 1), b2 + hstep, voffB); PG8_STAGE(PG8_SA(0, 0), a2, voffA);
            PG8_WAIT_V(8); PG8_WAIT_L(0); PG8_BAR; PG8_MMA(1, 0, At, B0); PG8_MMA(1, 1, At, B1); PG8_BAR; PG8_SCHED;
            PG8_LDB(B0, 1, 0); PG8_LDB(B1, 1, 1); PG8_SCHED; PG8_LDA(At, 1, 0); PG8_STAGE(PG8_SA(0, 1), a2 + hstep, voffA);
            PG8_WAIT_V(8); PG8_WAIT_L(0); PG8_BAR; PG8_MMA(0, 0, At, B0); PG8_MMA(0, 1, At, B1); PG8_BAR; PG8_SCHED;
            PG8_LDA(At, 1, 1); PG8_STAGE(PG8_SB(1, 0), b3, voffB); PG8_STAGE(PG8_SB(1, 1), b3 + hstep, voffB); PG8_STAGE(PG8_SA(1, 0), a3, voffA);
            PG8_WAIT_V(8); PG8_WAIT_L(0); PG8_BAR; PG8_MMA(1, 0, At, B0); PG8_MMA(1, 1, At, B1); PG8_BAR; PG8_SCHED;
            } else {
            PG8_LDB(B0, 0, 0); PG8_SCHED; PG8_LDA(At, 0, 0); PG8_STAGE(PG8_SA(1, 1), a1 + hstep, voffA);
            PG8_WAIT_L(8); PG8_BAR; PG8_WAIT_L(0); PG8_MMA(0, 0, At, B0); PG8_BAR; PG8_SCHED;
            PG8_LDB(B1, 0, 1); PG8_STAGE(PG8_SB(0, 0), b2, voffB);
            PG8_BAR; PG8_WAIT_L(0); PG8_MMA(0, 1, At, B1); PG8_BAR;
            PG8_LDA(At, 0, 1); PG8_STAGE(PG8_SA(0, 0), a2, voffA);
            PG8_BAR; PG8_WAIT_L(0); PG8_MMA(1, 0, At, B0); PG8_BAR; PG8_SCHED;
            PG8_STAGE(PG8_SB(0, 1), b2 + hstep, voffB);
            PG8_WAIT_V(6); PG8_BAR; PG8_MMA(1, 1, At, B1); PG8_BAR;
            PG8_LDB(B0, 1, 0); PG8_SCHED; PG8_LDA(At, 1, 0); PG8_STAGE(PG8_SA(0, 1), a2 + hstep, voffA);
            PG8_WAIT_L(8); PG8_BAR; PG8_WAIT_L(0); PG8_MMA(0, 0, At, B0); PG8_BAR; PG8_SCHED;
            PG8_LDB(B1, 1, 1); PG8_STAGE(PG8_SB(1, 0), b3, voffB);
            PG8_BAR; PG8_WAIT_L(0); PG8_MMA(0, 1, At, B1); PG8_BAR;
            PG8_LDA(At, 1, 1); PG8_STAGE(PG8_SA(1, 0), a3, voffA);
            PG8_BAR; PG8_WAIT_L(0); PG8_MMA(1, 0, At, B0); PG8_BAR; PG8_SCHED;
            PG8_STAGE(PG8_SB(1, 1), b3 + hstep, voffB);
            PG8_WAIT_V(6); PG8_BAR; PG8_MMA(1, 1, At, B1); PG8_BAR;
            }
        }
        if constexpr (ALIGN_EPI) { if (wr == 0) PG8_BAR; }
        if constexpr (!Epi::AFTER_DRAIN) { E(acc, cur, wr, wc, fr, fq); S.done(cur); }
        if (!has_next) break;
#pragma unroll
        for (int a = 0; a < 2; ++a)
#pragma unroll
            for (int b = 0; b < 2; ++b)
#pragma unroll
                for (int m = 0; m < 4; ++m)
#pragma unroll
                    for (int n = 0; n < 2; ++n) acc[a][b][m][n] = (f32x4){0.f, 0.f, 0.f, 0.f};
        cur = nxt; cA = nA; cB = nB; ++ui;
        if constexpr (ALIGN_EPI) { if (wr == 1) PG8_BAR; }
    }
    PG8_WAIT_V(0);
    if constexpr (!ALIGN_EPI) { if (wr == 0) PG8_BAR; }
    PG8_BAR;
    if constexpr (Epi::AFTER_DRAIN) { E.fused(acc, cur, wr, wc, fr, fq, lds, wid, lane); S.done(cur); }
#undef PG8_SA
#undef PG8_SB
#undef PG8_STAGE
#undef PG8_LDA
#undef PG8_LDB
#undef PG8_MMA
#undef PG8_WAIT_V
#undef PG8_WAIT_L
#undef PG8_BAR
#undef PG8_SCHED
}
}
namespace attn_body {
using bf16=__hip_bfloat16;
using bf16x8=__attribute__((ext_vector_type(8)))short;
using s16x4=__attribute__((ext_vector_type(4)))short;
using f32x16=__attribute__((ext_vector_type(16)))float;
using u32x4=__attribute__((ext_vector_type(4)))unsigned;
constexpr int D=64,PITCH=2304,OPITCH=1024,RPBATCH=2304;
constexpr int NW=8,QBLK=32,QB=QBLK*NW,KVBLK=64;
constexpr int ATTN_UNIT_ROWS=QB;
__device__ __forceinline__ int crow(int r,int hi){return (r&3)+8*(r>>2)+4*hi;}
#define SBAR() __builtin_amdgcn_sched_barrier(0)
__device__ __forceinline__ void cmask(f32x16&p0,f32x16&p1,int jb,int qrel,int hi){
  const float NEG=-INFINITY; int kb=64*jb+4*hi;
  #pragma unroll
  for(int r=0;r<16;++r){int kv=kb+(r&3)+8*(r>>2); if(kv>qrel)p0[r]=NEG; if(kv+32>qrel)p1[r]=NEG;}
}

template<int CK> __device__ __forceinline__ float sel_ck(float val,int c0,float neg){ int tmp; asm volatile("v_add_u32_e32 %1, %3, %2\n\tv_cmp_gt_u32_e32 vcc, 16, %1\n\tv_cndmask_b32_e32 %0, %4, %0, vcc":"+v"(val),"=&v"(tmp):"v"(c0),"n"(CK),"v"(neg):"vcc"); return val;}
__device__ __forceinline__ void na_mask(f32x16&p0,f32x16&p1,int t,int kr0,int rq,int rs,int cq,int cs,int hi,int h,const float*tab){
  if(t<4)return;
  const float NEG=-INFINITY; const int kr=kr0+t-4;
  if(kr<rs||kr>=rs+8){
    #pragma unroll
    for(int r=0;r<16;++r){p0[r]=NEG;p1[r]=NEG;}
    return; }
  const float*brow=tab+(kr-rq+7)*32+15-cq+4*hi; const int c0=4*hi-cs;
  #define CKOF(r) (((r)&3)+8*((r)>>2))
  #define NA1(r) do{ const float b0=brow[CKOF(r)], b1=brow[CKOF(r)+32]; p0[r]=sel_ck<CKOF(r)>(p0[r]+b0,c0,NEG); p1[r]=sel_ck<CKOF(r)+32>(p1[r]+b1,c0,NEG); }while(0)
  #define NA0(r) do{ const float b0=brow[CKOF(r)]; p0[r]=sel_ck<CKOF(r)>(p0[r]+b0,c0,NEG); }while(0)
  #define NA2(r) do{ const float b1=brow[CKOF(r)+32]; p1[r]=sel_ck<CKOF(r)+32>(p1[r]+b1,c0,NEG); }while(0)
  if(h==0){
    NA1(0);NA1(1);NA1(2);NA1(3); asm volatile("":::"memory");
    NA0(4);NA0(5);NA0(6);NA0(7);NA0(8);NA0(9);NA0(10);NA0(11); asm volatile("":::"memory");
    NA0(12);NA0(13);NA0(14);NA0(15);
    #pragma unroll
    for(int r=4;r<16;++r)p1[r]=NEG;
  } else {
    NA1(12);NA1(13);NA1(14);NA1(15); asm volatile("":::"memory");
    NA2(0);NA2(1);NA2(2);NA2(3);NA2(4);NA2(5);NA2(6);NA2(7); asm volatile("":::"memory");
    NA2(8);NA2(9);NA2(10);NA2(11);
    #pragma unroll
    for(int r=0;r<12;++r)p0[r]=NEG;
  }
  #undef NA0
  #undef NA2
  #undef NA1
  #undef CKOF
}
constexpr int NSLOT=3, SLOTB=8192;
constexpr int LDS_K=0, LDS_V=NSLOT*SLOTB, LDS_WS=2*NSLOT*SLOTB, LDS_OST=LDS_WS+NW*64*4, LDS_BYTES=LDS_OST+NW*4096;
constexpr float C2=0.125f*1.4426950408889634f;
__device__ __forceinline__ void glds16(const void*gsrc,unsigned lds_dst){unsigned keep;
  asm volatile("s_mov_b32 %0, m0\n\ts_mov_b32 m0, %2\n\ts_nop 0\n\tglobal_load_lds_dwordx4 %1, off\n\ts_mov_b32 m0, %0":"=&s"(keep):"v"(gsrc),"s"(lds_dst):"memory");}
__device__ __forceinline__ void glds16s(const void*sbase,unsigned voff,unsigned lds_dst){unsigned keep;
  asm volatile("s_mov_b32 %0, m0\n\ts_mov_b32 m0, %3\n\ts_nop 0\n\tglobal_load_lds_dwordx4 %1, %2\n\ts_mov_b32 m0, %0":"=&s"(keep):"v"(voff),"s"(sbase),"s"(lds_dst):"memory");}
__device__ __forceinline__ float max3f(float a,float b,float c){float r;asm("v_max3_f32 %0, %1, %2, %3":"=v"(r):"v"(a),"v"(b),"v"(c));return r;}
__device__ __forceinline__ float max2f(float a,float b){float r;asm("v_max_f32_e32 %0, %1, %2":"=v"(r):"v"(a),"v"(b));return r;}
__device__ __forceinline__ float fadd_s(float a,float b){float r;asm("v_add_f32_e32 %0, %1, %2":"=v"(r):"v"(a),"v"(b));return r;}
__device__ __forceinline__ float fsub_s(float a,float b){float r;asm("v_sub_f32_e32 %0, %1, %2":"=v"(r):"v"(a),"v"(b));return r;}
typedef float f32x2_t __attribute__((ext_vector_type(2))); typedef __bf16 bf16x2_t __attribute__((ext_vector_type(2)));
__device__ __forceinline__ unsigned cvtpk_s(float lo,float hi){f32x2_t v={lo,hi};bf16x2_t b=__builtin_convertvector(v,bf16x2_t);return __builtin_bit_cast(unsigned,b);}
#define WAIT_BAR(N) asm volatile("s_waitcnt vmcnt(" #N ") lgkmcnt(0)\n\ts_barrier":::"memory")

__device__ __forceinline__ void qkt(f32x16&p0,f32x16&p1,const char*Kslot,const bf16x8*qr,const f32x16&negm,int r32,int hi){
  const char*kb=Kslot+hi*1024+r32*16;
  #pragma unroll
  for(int d0=0;d0<4;++d0){
    const bf16x8 b0=*reinterpret_cast<const bf16x8*>(kb+d0*2048);
    const bf16x8 b1=*reinterpret_cast<const bf16x8*>(kb+d0*2048+512);
    if(d0==0){p0=__builtin_amdgcn_mfma_f32_32x32x16_bf16(b0,qr[0],negm,0,0,0);p1=__builtin_amdgcn_mfma_f32_32x32x16_bf16(b1,qr[0],negm,0,0,0);}
    else{p0=__builtin_amdgcn_mfma_f32_32x32x16_bf16(b0,qr[d0],p0,0,0,0);p1=__builtin_amdgcn_mfma_f32_32x32x16_bf16(b1,qr[d0],p1,0,0,0);}}
}
typedef __attribute__((address_space(3))) const char* lds_cptr;
typedef short v4i16_t __attribute__((ext_vector_type(4)));
__device__ __forceinline__ void kload8(bf16x8*kf,lds_cptr kp){
  kf[0]=*(const __attribute__((address_space(3))) bf16x8*)(kp);      kf[1]=*(const __attribute__((address_space(3))) bf16x8*)(kp+512);
  kf[2]=*(const __attribute__((address_space(3))) bf16x8*)(kp+2048); kf[3]=*(const __attribute__((address_space(3))) bf16x8*)(kp+2560);
  kf[4]=*(const __attribute__((address_space(3))) bf16x8*)(kp+4096); kf[5]=*(const __attribute__((address_space(3))) bf16x8*)(kp+4608);
  kf[6]=*(const __attribute__((address_space(3))) bf16x8*)(kp+6144); kf[7]=*(const __attribute__((address_space(3))) bf16x8*)(kp+6656);
}
__device__ __forceinline__ void kload2(bf16x8*kf,lds_cptr kp,int j){ kf[2*j]=*(const __attribute__((address_space(3))) bf16x8*)(kp+j*2048); kf[2*j+1]=*(const __attribute__((address_space(3))) bf16x8*)(kp+j*2048+512); }
__device__ __forceinline__ s16x4 vtr(lds_cptr p){ return __builtin_bit_cast(s16x4,__builtin_amdgcn_ds_read_tr16_b64_v4i16((__attribute__((address_space(3))) v4i16_t*)p)); }
__device__ __forceinline__ float rowmax(const f32x16&p0,const f32x16&p1){
  float a=max3f(p0[0],p0[1],p1[0]),b=max3f(p0[2],p0[3],p1[1]);a=max3f(a,p1[2],p1[3]);
  #pragma unroll
  for(int r=4;r<16;r+=4){a=max3f(a,p0[r],p0[r+1]);b=max3f(b,p0[r+2],p0[r+3]);a=max3f(a,p1[r],p1[r+1]);b=max3f(b,p1[r+2],p1[r+3]);}
  const float m=max2f(a,b);
  auto rr=__builtin_amdgcn_permlane32_swap(__float_as_uint(m),__float_as_uint(m),false,false);
  return max2f(__uint_as_float(rr[0]),__uint_as_float(rr[1]));
}
__device__ __forceinline__ void pv(f32x16*o,int vb,bf16x8 pa0,bf16x8 pa1,bf16x8 pa2,bf16x8 pa3){
  #pragma unroll
  for(int d0=0;d0<2;++d0){s16x4 lo[4],hi[4];
    #pragma unroll
    for(int ks=0;ks<4;++ks){
      asm volatile("ds_read_b64_tr_b16 %0,%1 offset:%c2":"=&v"(lo[ks]):"v"(vb),"i"(d0*4096+ks*1024):"memory");
      asm volatile("ds_read_b64_tr_b16 %0,%1 offset:%c2":"=&v"(hi[ks]):"v"(vb),"i"(d0*4096+ks*1024+512):"memory");}
    asm volatile("s_waitcnt lgkmcnt(0)":::"memory");SBAR();
    #define PK(k) (bf16x8){lo[k][0],lo[k][1],lo[k][2],lo[k][3],hi[k][0],hi[k][1],hi[k][2],hi[k][3]}
    o[d0]=__builtin_amdgcn_mfma_f32_32x32x16_bf16(pa0,PK(0),o[d0],0,0,0);
    o[d0]=__builtin_amdgcn_mfma_f32_32x32x16_bf16(pa1,PK(1),o[d0],0,0,0);
    o[d0]=__builtin_amdgcn_mfma_f32_32x32x16_bf16(pa2,PK(2),o[d0],0,0,0);
    o[d0]=__builtin_amdgcn_mfma_f32_32x32x16_bf16(pa3,PK(3),o[d0],0,0,0);
    #undef PK
  }
}

#ifndef ATTN_STORE16
#define ATTN_STORE16(p,v) (*(u32x4*)(p)=(v))
#endif
template<int MODE,int THRL> __device__ __forceinline__ void attn_unit(int b,int q0,int qcol,int kcol,int vcol,int ocol,int tb,int NTin,int kr0,const float*rpbh,const bf16*QKV,bf16*O,char*shm){
  int tid_=threadIdx.x; asm volatile("":"+v"(tid_)); const int tid=tid_,lane=tid&63,r32=lane&31,hi=lane>>5; const int wid=__builtin_amdgcn_readfirstlane(tid>>6);
  const long rowbase=(long)b*RPBATCH;
  const bf16*Qw=QKV+(rowbase+q0+wid*QBLK)*PITCH+qcol;
  const bf16*Kh=QKV+rowbase*PITCH+kcol,*Vh=QKV+rowbase*PITCH+vcol;
  const unsigned lds0=(unsigned)(uintptr_t)shm;
  float*wsf=(float*)(shm+LDS_WS)+wid*64;
  const unsigned koff=(unsigned)(lane*PITCH+wid*8)*2u;
  const unsigned voffv=(unsigned)((16*(wid&3)+(lane>>2))*PITCH+(wid>>2)*32+(lane&3)*8)*2u;
  const unsigned kdst=lds0+LDS_K+wid*1024, vdst=lds0+LDS_V+wid*1024;
  #define TROW(t) ((MODE==1)?(((t)<4)?(2048+64*(t)):(64*(kr0+(t)-4))):(tb+64*(t)))
  #define DMA_K(t,slot) glds16s(Kh+(long)TROW(t)*PITCH,koff,(unsigned)__builtin_amdgcn_readfirstlane(kdst+(slot)))
  #define DMA_V(t,slot) glds16s(Vh+(long)TROW(t)*PITCH,voffv,(unsigned)__builtin_amdgcn_readfirstlane(vdst+(slot)))
  const int vb0=(int)(lds0+LDS_V)+((lane>>4)&1)*32+(lane&3)*8+(4*hi+((lane&15)>>2))*64;
  const char*Kbase=shm+LDS_K; bf16x8 kf[8];
  const lds_cptr shm3=(lds_cptr)shm; const lds_cptr kp0=shm3+LDS_K+hi*1024+r32*16; const lds_cptr vp0=shm3+LDS_V+((lane>>4)&1)*32+(lane&3)*8+(4*hi+((lane&15)>>2))*64;
  const int NT=(MODE==1)?16:NTin;
  const int rq=(q0>>6)+(wid>>1), cq=(wid&1)*32+r32; const int rs=min(max(rq-4,0),24), cs=min(max(cq-8,0),48);
  float*tab=(float*)(shm+LDS_BYTES);
  if(MODE==1){ for(int i=tid;i<15*32;i+=NW*64){const int ii=i>>5,jj=i&31; tab[i]=(jj<31)?rpbh[ii*31+jj]*1.4426950408889634f:0.f;} }
  DMA_K(0,0);DMA_V(0,0);DMA_K(1,SLOTB);
  bf16x8 qr[4];
  #pragma unroll
  for(int d0=0;d0<4;++d0)qr[d0]=*reinterpret_cast<const bf16x8*>(&Qw[(long)r32*PITCH+d0*16+hi*8]);
  float mhat=0.f,l_reg=0.f;f32x16 o[2];o[0]=f32x16{};o[1]=f32x16{};const f32x16 negm=f32x16{};
  const int qrel=wid*QBLK+r32;
  #define CMASK(P0,P1,t) do{ if(MODE==1) na_mask(P0,P1,(t),kr0,rq,rs,cq,cs,hi,wid&1,tab); }while(0)
  bool resc=false;
  #define START(P0,P1) do{ const float rm=rowmax(P0,P1); resc=false; \
    { const float dl=rm; mhat=fadd_s(mhat,dl); \
      _Pragma("unroll") for(int r=0;r<16;++r){P0[r]=fsub_s(P0[r],dl);P1[r]=fsub_s(P1[r],dl);} \
      } \
    _Pragma("unroll") for(int r=0;r<16;++r)P0[r]=__builtin_amdgcn_exp2f(P0[r]); }while(0)
  #define RESC() do{ if(resc){ asm volatile("s_waitcnt lgkmcnt(0)":::"memory"); \
      _Pragma("unroll") for(int d_=0;d_<2;++d_) _Pragma("unroll") for(int r=0;r<16;++r)o[d_][r]*=wsf[crow(r,hi)]; } }while(0)
  f32x16 pA0,pA1,pB0,pB1;
  int sl_prev=0,sl_cur=0,sl_next=SLOTB;
  #define ROT() do{sl_prev=sl_cur;sl_cur=sl_next;sl_next=(sl_next==(NSLOT-1)*SLOTB)?0:sl_next+SLOTB;}while(0)
  DMA_K(2,2*SLOTB);
  WAIT_BAR(3);
  qkt(pA0,pA1,Kbase,qr,negm,r32,hi);asm volatile("s_nop 15\n\ts_nop 7":"+v"(pA0),"+v"(pA1));CMASK(pA0,pA1,0);
  START(pA0,pA1);
  _Pragma("unroll") for(int r=0;r<16;++r)pA1[r]=__builtin_amdgcn_exp2f(pA1[r]);
  WAIT_BAR(0);
  DMA_K(3,0);DMA_V(1,SLOTB);
  ROT();
  kload8(kf,kp0+sl_cur);
  WAIT_BAR(2);
  s16x4 vlo[8],vhi[8]; u32x4 pw0,pw1,pw2,pw3;
  #define PKW(P,B) cvtpk_s(P[B],P[B+1])
  #define PAF(k) __builtin_bit_cast(bf16x8,pw##k)
  #define VFR(i) (bf16x8){vlo[i][0],vlo[i][1],vlo[i][2],vlo[i][3],vhi[i][0],vhi[i][1],vhi[i][2],vhi[i][3]}
  #define PIN(x) asm volatile("":"+v"(x))
  #define MX3(a,b,c) __builtin_fmaxf(__builtin_fmaxf((a),(b)),(c))
  #define GAPA(MF,A0,A1,A2,A3,W0,W1,PW) do{ MF; sacc+=A0; sacc+=A1; sacc+=A2; sacc+=A3; PIN(sacc); W0; W1; PIN(PW); SBAR(); }while(0)
  #define EX(v) __builtin_amdgcn_exp2f(v)
  #define GAPB(MF,X,B) do{ MF; X[B]=EX(X[B]); X[B+1]=EX(X[B+1]); X[B+2]=EX(X[B+2]); X[B+3]=EX(X[B+3]); PIN(X); SBAR(); }while(0)
  #define VRD(i) do{ vlo[i]=vtr(vp_+(((i)>>2)*4096+((i)&3)*1024)); vhi[i]=vtr(vp_+(((i)>>2)*4096+((i)&3)*1024+512)); }while(0)
  #define KRD(G,j) do{ if(G){ kload2(kf,kp0+sl_next,j); SBAR(); } }while(0)
  #define STEP(C0,C1,P0,P1,t,GK,GV,GL) do{ SBAR(); \
    const lds_cptr vp_=vp0+sl_prev; \
    VRD(0); SBAR(); float sacc=(P0[0]+P0[1]); \
    GAPA(C0=__builtin_amdgcn_mfma_f32_32x32x16_bf16(kf[0],qr[0],negm,0,0,0), P0[2],P0[3],P0[4],P0[5],     pw0[0]=PKW(P0,0), pw0[1]=PKW(P0,2), pw0); \
    VRD(4); SBAR(); GAPA(C1=__builtin_amdgcn_mfma_f32_32x32x16_bf16(kf[1],qr[0],negm,0,0,0), P0[6],P0[7],P0[8],P0[9],     pw0[2]=PKW(P0,4), pw0[3]=PKW(P0,6), pw0); \
    VRD(1); SBAR(); GAPA(C0=__builtin_amdgcn_mfma_f32_32x32x16_bf16(kf[2],qr[1],C0,0,0,0),   P0[10],P0[11],P0[12],P0[13], pw1[0]=PKW(P0,8), pw1[1]=PKW(P0,10), pw1); \
    VRD(5); SBAR(); GAPA(C1=__builtin_amdgcn_mfma_f32_32x32x16_bf16(kf[3],qr[1],C1,0,0,0),   P0[14],P0[15],P1[0],P1[1],   pw1[2]=PKW(P0,12),pw1[3]=PKW(P0,14), pw1); \
    VRD(2); SBAR(); GAPA(C0=__builtin_amdgcn_mfma_f32_32x32x16_bf16(kf[4],qr[2],C0,0,0,0),   P1[2],P1[3],P1[4],P1[5],     pw2[0]=PKW(P1,0), pw2[1]=PKW(P1,2), pw2); \
    VRD(6); SBAR(); GAPA(C1=__builtin_amdgcn_mfma_f32_32x32x16_bf16(kf[5],qr[2],C1,0,0,0),   P1[6],P1[7],P1[8],P1[9],     pw2[2]=PKW(P1,4), pw2[3]=PKW(P1,6), pw2); \
    VRD(3); SBAR(); GAPA(C0=__builtin_amdgcn_mfma_f32_32x32x16_bf16(kf[6],qr[3],C0,0,0,0),   P1[10],P1[11],P1[12],P1[13], pw3[0]=PKW(P1,8), pw3[1]=PKW(P1,10), pw3); \
    VRD(7); SBAR(); GAPA(C1=__builtin_amdgcn_mfma_f32_32x32x16_bf16(kf[7],qr[3],C1,0,0,0),   P1[14],P1[15],0.f,0.f,       pw3[2]=PKW(P1,12),pw3[3]=PKW(P1,14), pw3); \
    l_reg+=sacc; \
    if(GK){DMA_K((t)+3,sl_cur);} if(GV){DMA_V((t)+1,sl_next);} \
    _Pragma("unroll") for(int r=0;r<16;++r){C0[r]-=mhat;C1[r]-=mhat;} \
    CMASK(C0,C1,t); \
    { float a=MX3(C0[0],C0[1],C1[0]),b=MX3(C0[2],C0[3],C1[1]); a=MX3(a,C1[2],C1[3]); \
      _Pragma("unroll") for(int r=4;r<16;r+=4){a=MX3(a,C0[r],C0[r+1]);b=MX3(b,C0[r+2],C0[r+3]);a=MX3(a,C1[r],C1[r+1]);b=MX3(b,C1[r+2],C1[r+3]);} \
      float rm=__builtin_fmaxf(a,b); { auto rr=__builtin_amdgcn_permlane32_swap(__float_as_uint(rm),__float_as_uint(rm),false,false); rm=__builtin_fmaxf(__uint_as_float(rr[0]),__uint_as_float(rr[1])); } \
      resc=false; \
      if(__builtin_expect(__any(rm>(float)THRL),0)){ const float dl=__builtin_fmaxf(rm,0.f); mhat+=dl; \
        _Pragma("unroll") for(int r=0;r<16;++r){C0[r]-=dl;C1[r]-=dl;} \
        const float f=__builtin_amdgcn_exp2f(-dl); l_reg*=f; if(hi==0)wsf[r32]=f; resc=true; } } \
    SBAR(); \
    GAPB(o[0]=__builtin_amdgcn_mfma_f32_32x32x16_bf16(PAF(0),VFR(0),o[0],0,0,0), C0,0); \
    GAPB(o[1]=__builtin_amdgcn_mfma_f32_32x32x16_bf16(PAF(0),VFR(4),o[1],0,0,0), C0,4); \
    KRD(GL,0); GAPB(o[0]=__builtin_amdgcn_mfma_f32_32x32x16_bf16(PAF(1),VFR(1),o[0],0,0,0), C0,8); \
    KRD(GL,1); GAPB(o[1]=__builtin_amdgcn_mfma_f32_32x32x16_bf16(PAF(1),VFR(5),o[1],0,0,0), C0,12); \
    KRD(GL,2); GAPB(o[0]=__builtin_amdgcn_mfma_f32_32x32x16_bf16(PAF(2),VFR(2),o[0],0,0,0), C1,0); \
    KRD(GL,3); GAPB(o[1]=__builtin_amdgcn_mfma_f32_32x32x16_bf16(PAF(2),VFR(6),o[1],0,0,0), C1,4); \
    GAPB(o[0]=__builtin_amdgcn_mfma_f32_32x32x16_bf16(PAF(3),VFR(3),o[0],0,0,0), C1,8); \
    GAPB(o[1]=__builtin_amdgcn_mfma_f32_32x32x16_bf16(PAF(3),VFR(7),o[1],0,0,0), C1,12); \
    }while(0)
  int t=1;
  _Pragma("nounroll") for(;t+5<NT;t+=2){
    STEP(pB0,pB1,pA0,pA1,t,true,true,true);     WAIT_BAR(2); RESC(); ROT();
    STEP(pA0,pA1,pB0,pB1,t+1,true,true,true);   WAIT_BAR(2); RESC(); ROT();
  }
  #define ENDW(tt) do{ if((tt)+3<NT){WAIT_BAR(2);} else if((tt)+2<NT){WAIT_BAR(1);} else {WAIT_BAR(0);} }while(0)
  _Pragma("nounroll") for(;t+1<NT;t+=2){
    STEP(pB0,pB1,pA0,pA1,t,(t+3<NT),(t+1<NT),(t+1<NT));       ENDW(t);   RESC(); ROT();
    STEP(pA0,pA1,pB0,pB1,t+1,(t+4<NT),(t+2<NT),(t+2<NT));     ENDW(t+1); RESC(); ROT();
  }
  STEP(pB0,pB1,pA0,pA1,NT-1,false,false,false); RESC();
  { float sacc=pB0[0]+pB0[1]; _Pragma("unroll") for(int r=2;r<16;++r)sacc+=pB0[r]; _Pragma("unroll") for(int r=0;r<16;++r)sacc+=pB1[r]; l_reg+=sacc;
    pw0=(u32x4){PKW(pB0,0),PKW(pB0,2),PKW(pB0,4),PKW(pB0,6)};pw1=(u32x4){PKW(pB0,8),PKW(pB0,10),PKW(pB0,12),PKW(pB0,14)};pw2=(u32x4){PKW(pB1,0),PKW(pB1,2),PKW(pB1,4),PKW(pB1,6)};pw3=(u32x4){PKW(pB1,8),PKW(pB1,10),PKW(pB1,12),PKW(pB1,14)};
    SBAR(); pv(o,vb0+sl_cur,PAF(0),PAF(1),PAF(2),PAF(3)); }
  #undef PKW
  #undef PAF
  #undef VFR
  #undef PIN
  #undef MX3
  #undef GAPA
  #undef GAPB
  #undef EX
  #undef VRD
  #undef KRD
  #undef STEP
  #undef ENDW
  {auto rr=__builtin_amdgcn_permlane32_swap(__float_as_uint(l_reg),__float_as_uint(l_reg),false,false);l_reg=__uint_as_float(rr[0])+__uint_as_float(rr[1]);}
  if(hi==0)wsf[32+r32]=l_reg;asm volatile("s_waitcnt lgkmcnt(0)":::"memory");
  float rli[16];
  #pragma unroll
  for(int r=0;r<16;++r)rli[r]=__builtin_amdgcn_rcpf(wsf[32+crow(r,hi)]);
  bf16*Ow=O+(rowbase+q0+wid*QBLK)*OPITCH+ocol;
  { bf16*stg=(bf16*)(shm+LDS_OST)+wid*2048;
    #pragma unroll
    for(int r=0;r<16;++r){const int orow=crow(r,hi);
      #pragma unroll
      for(int d0=0;d0<2;++d0)stg[orow*64+d0*32+r32]=__float2bfloat16(o[d0][r]*rli[r]);}
    asm volatile("s_waitcnt lgkmcnt(0)":::"memory");
    #pragma unroll
    for(int i=0;i<4;++i){const int row=i*8+(lane>>3),ch=lane&7; const u32x4 v=*(const u32x4*)(stg+row*64+ch*8); ATTN_STORE16(Ow+(long)row*OPITCH+ch*8,v);} }
  asm volatile("s_waitcnt lgkmcnt(0)\n\ts_barrier":::"memory");
  #undef DMA_K
  #undef TROW
  #undef DMA_V
  #undef CMASK
  #undef START
  #undef RESC
  #undef ROT
}
constexpr int ATTN_LDS_BYTES=LDS_BYTES+2048;
#undef SBAR
#undef WAIT_BAR
}
constexpr int NWAVES = 8;
constexpr int DMODEL = 1024, NBATCH = 8, SEQL = 2048, CTXL = 256, RPB = SEQL + CTXL  , MROWS = NBATCH * RPB  ;
constexpr int DFF = 2816, N13 = 2 * DFF, NIN = 2304, NMOD = 9, MODW = NMOD * DMODEL;
constexpr float EPS = 1e-6f;
constexpr float QC2 = 0.125f * 1.4426950408889634f;
constexpr size_t MiB = 1u << 20;
constexpr size_t WS_CTL = 0, CTL_ZERO_BYTES = 1 * MiB;
constexpr size_t WS_MODS = 1 * MiB;
constexpr size_t WS_ROPE = 2 * MiB;
constexpr size_t WS_W = 3 * MiB;
constexpr size_t SZ_W13 = (size_t)N13 * DMODEL * 2, SZ_W2 = (size_t)DMODEL * DFF * 2, SZ_WIN = (size_t)NIN * DMODEL * 2, SZ_WOUT = (size_t)DMODEL * DMODEL * 2;
constexpr size_t OFF_W13A = 0, OFF_W2A = OFF_W13A + SZ_W13, OFF_WIN = OFF_W2A + SZ_W2, OFF_WOUT = OFF_WIN + SZ_WIN, OFF_W13B = OFF_WOUT + SZ_WOUT, OFF_W2B = OFF_W13B + SZ_W13, SZ_WLAYER = OFF_W2B + SZ_W2;
constexpr size_t WS_XS = WS_W + 2 * SZ_WLAYER;
constexpr size_t WS_U = WS_XS + (size_t)MROWS * DMODEL * 4;
constexpr size_t WS_O = WS_U + (size_t)MROWS * DFF * 2;
constexpr size_t WS_END = WS_O + (size_t)MROWS * DMODEL * 2;
static_assert(WS_O == WS_O_BYTES && WS_END == WS_END_BYTES && WS_U == WS_U_BYTES, "slab offsets");
static_assert(WS_XS % 256 == 0 && WS_U % 256 == 0 && WS_O % 256 == 0, "alignment");
constexpr int CW_BAR = 4096;
constexpr int RING_BYTES = 131072, LDSCTL_OFF = RING_BYTES, MISC_OFF = LDSCTL_OFF + 320, LDS_BYTES = 147456, ROPE_LDS_OFF = RING_BYTES + 2048;
static_assert(ROPE_LDS_OFF + 8192 <= LDS_BYTES && MISC_OFF + 128 <= ROPE_LDS_OFF, "LDS map");

#define GAS __attribute__((address_space(1)))
#define LAS __attribute__((address_space(3)))
typedef unsigned short bf16;
typedef unsigned v4u __attribute__((ext_vector_type(4)));
typedef unsigned v2u __attribute__((ext_vector_type(2)));
typedef float f32x4 __attribute__((ext_vector_type(4)));
typedef float f32x2 __attribute__((ext_vector_type(2)));
#define LDS_WAIT() asm volatile("s_waitcnt lgkmcnt(0)" ::: "memory")
__device__ __forceinline__ unsigned f2bf(float f) { unsigned u = __builtin_bit_cast(unsigned, f); return (u + 0x7fffu + ((u >> 16) & 1u)) >> 16; }
__device__ __forceinline__ unsigned pk2(float lo, float hi) { return f2bf(lo) | (f2bf(hi) << 16); }
__device__ __forceinline__ float bf2f(unsigned short h) { return __builtin_bit_cast(float, (unsigned)h << 16); }
__device__ __forceinline__ float wave_sum(float v) {
#pragma unroll
    for (int o = 1; o < 64; o <<= 1) v += __shfl_xor(v, o);
    return v;
}
#define RLX_AGENT __ATOMIC_RELAXED, __HIP_MEMORY_SCOPE_AGENT
#define XB_TMO      128
#define XB_XCNT(j)  (256  + 64 * (j))
#define XB_XSUB(j)  (1280 + 64 * (j))
#define XB_XGEN(j)  (2304 + 64 * (j))
#define XB_TOP      3328
#define XB_TOPGEN   3392
#define XCD_BAR_WORDS 3456
#define XB_SPIN_CAP (1u << 18)

__device__ __forceinline__ unsigned xb_ld(unsigned* p)              { return __hip_atomic_load(p, __ATOMIC_RELAXED, __HIP_MEMORY_SCOPE_AGENT); }
__device__ __forceinline__ unsigned xb_add(unsigned* p, unsigned v) { return __hip_atomic_fetch_add(p, v, __ATOMIC_RELAXED, __HIP_MEMORY_SCOPE_AGENT); }
__device__ __forceinline__ unsigned xb_xcc_id() { return (unsigned)__builtin_amdgcn_s_getreg((3 << 11) | 20) & 0xFu; }
#define XB_SPIN(cond, bar) do { unsigned _sp = 0; while (cond) { __builtin_amdgcn_s_sleep(1); \
    if ((++_sp & 255u) == 0u) { if (xb_ld(&(bar)[XB_TMO])) break; if (_sp > XB_SPIN_CAP) { atomicAdd(&(bar)[XB_TMO], 1u); break; } } } } while (0)

struct XcdBarrier {
    unsigned* bar; unsigned x;
    volatile LAS unsigned* st;
};

__device__ __forceinline__ XcdBarrier xcd_barrier_post(unsigned* bar, volatile LAS unsigned* st) {
    XcdBarrier b; b.bar = bar; b.x = xb_xcc_id(); b.st = st;
    if (threadIdx.x == 0) (void)xb_add(&bar[XB_XCNT(b.x)], 1u);
    return b;
}
__device__ __forceinline__ void xcd_barrier_complete(unsigned* bar, unsigned x, unsigned& nloc, unsigned& nx) {
    const unsigned G = gridDim.x * gridDim.y * gridDim.z;
    unsigned sum, cnt, mine, sp = 0u;
    for (;;) {
        sum = 0u; cnt = 0u; mine = 0u;
#pragma unroll
        for (unsigned j = 0; j < 16; ++j) { const unsigned c = xb_ld(&bar[XB_XCNT(j)]); sum += c; cnt += (c > 0u) ? 1u : 0u; mine = (j == x) ? c : mine; }
        if (sum == G) break;
        __builtin_amdgcn_s_sleep(1);
        if ((++sp & 255u) == 0u) { if (xb_ld(&bar[XB_TMO])) break; if (sp > XB_SPIN_CAP) { atomicAdd(&bar[XB_TMO], 1u); break; } }
    }
    nloc = mine > 0u ? mine : 1u; nx = cnt > 0u ? cnt : 1u;
}

__device__ __forceinline__ void xcd_barrier(const XcdBarrier& b) {
    asm volatile("s_waitcnt vmcnt(0)" ::: "memory");
    __syncthreads();
    if (threadIdx.x == 0) {
        unsigned* bar = b.bar;
        __builtin_amdgcn_s_waitcnt(0);
        unsigned nloc = b.st[0], nx = b.st[1];
        if (nloc == 0u) { xcd_barrier_complete(bar, b.x, nloc, nx); b.st[0] = nloc; b.st[1] = nx; }
        const unsigned old = xb_add(&bar[XB_XSUB(b.x)], 1u);
        const unsigned gen = old / nloc;
        if (old + 1u == (gen + 1u) * nloc) {
            __builtin_amdgcn_fence(__ATOMIC_RELEASE, "agent");
            asm volatile("s_waitcnt vmcnt(0)" ::: "memory");
            const unsigned og = xb_add(&bar[XB_TOP], 1u);
            const unsigned tg = og / nx;
            if (og + 1u == (tg + 1u) * nx) xb_add(&bar[XB_TOPGEN], 1u);
            else XB_SPIN(xb_ld(&bar[XB_TOPGEN]) == tg, bar);
            __builtin_amdgcn_fence(__ATOMIC_ACQUIRE, "agent");
            xb_add(&bar[XB_XGEN(b.x)], 1u);
            asm volatile("s_waitcnt vmcnt(0)" ::: "memory");
        } else {
            XB_SPIN(xb_ld(&bar[XB_XGEN(b.x)]) == gen, bar);
            __builtin_amdgcn_fence(__ATOMIC_ACQUIRE, "agent");
            asm volatile("s_waitcnt vmcnt(0)" ::: "memory");
        }
    }
    __syncthreads();
}
struct Args {
    const float* in[21]; float* out; unsigned char* ws; int pad0, pad1;
};
typedef const __attribute__((address_space(4))) Args* ArgsP;
__device__ __forceinline__ ArgsP get_args() { ArgsP p = (ArgsP)__builtin_amdgcn_kernarg_segment_ptr(); asm volatile("" : "+s"(p)); return p; }
struct Frame {
    LAS unsigned char* lds; int tid, lane, wave, vcu, G;
    __device__ __forceinline__ void refresh() { int t = threadIdx.x; asm volatile("" : "+v"(t)); tid = t; lane = t & 63; wave = __builtin_amdgcn_readfirstlane(t >> 6); }
};
template <int MAP> __device__ __forceinline__ int map_dest(int s) {
    if (MAP == 1) { const int bj = s >= DFF ? 1 : 0, r = s - bj * DFF; return (r >> 7) * 256 + bj * 128 + (r & 127); }
    if (MAP == 2) { const int pn = s >> 8, rem = s & 255, wc = rem >> 6, bj = (rem >> 5) & 1, x = rem & 31, hh = pn * 4 + wc;
        if (hh >= 24 && hh < 34) { const int nn = (x >> 4) & 1, fq = (x >> 2) & 3, e = x & 3; return pn * 256 + bj * 128 + wc * 32 + fq * 8 + nn * 4 + e; }
        return pn * 256 + bj * 128 + wc * 32 + x; }
    return s;
}
template <int MAP> __device__ __forceinline__ void p0_transpose_item(const float* W, int K, int N, bf16* WT, LAS float* scr, int item, int lane) {
    const int nblk = N / 32, kb = item / nblk, nb = item % nblk, k0 = 64 * kb, n0 = 32 * nb;
#pragma unroll 8
    for (int i = 0; i < 32; ++i) { const int kk = 2 * i + (lane >> 5); scr[kk * 33 + (lane & 31)] = W[(size_t)(k0 + kk) * N + n0 + (lane & 31)]; }
    LDS_WAIT(); asm volatile("" ::: "memory");
    const int c = lane & 7;
#pragma unroll
    for (int j = 0; j < 4; ++j) { const int n = (lane >> 3) + 8 * j; const LAS float* s = scr + (8 * c) * 33 + n;
        v4u o; o.x = pk2(s[0 * 33], s[1 * 33]); o.y = pk2(s[2 * 33], s[3 * 33]); o.z = pk2(s[4 * 33], s[5 * 33]); o.w = pk2(s[6 * 33], s[7 * 33]);
        *(GAS v4u*)(WT + (size_t)map_dest<MAP>(n0 + n) * K + k0 + 8 * c) = o; }
    LDS_WAIT(); asm volatile("" ::: "memory");
}
__device__ __forceinline__ void p0_mod_unit(const Frame& F, int unit, const float* c, const float* cctx, const float* wmod, const float* bmod, float* mods) {
    const int layer = unit / 72, col0 = (unit % 72) * 128;
    LAS float* sc = (LAS float*)F.lds;
    LAS float* red = sc + 9 * 1024;
    for (int i = F.tid; i < 9 * 1024; i += NWAVES * 64) { const int j = i >> 10, k = i & 1023; const float v = j < 8 ? c[j * 1024 + k] : cctx[k]; sc[i] = v / (1.0f + expf(-v)); }
    __syncthreads();
    const float* W = wmod + (size_t)layer * 1024 * MODW + col0 + 2 * F.lane;
    float a0[9], a1[9];
#pragma unroll
    for (int j = 0; j < 9; ++j) { a0[j] = 0.f; a1[j] = 0.f; }
    const int kw = F.wave * 128;
    for (int kk = 0; kk < 128; kk += 8) {
        f32x2 w[8];
#pragma unroll
        for (int q = 0; q < 8; ++q) w[q] = *(const f32x2*)(W + (size_t)(kw + kk + q) * MODW);
#pragma unroll
        for (int q = 0; q < 8; ++q)
#pragma unroll
            for (int j = 0; j < 9; ++j) { const float s = sc[j * 1024 + kw + kk + q]; a0[j] += s * w[q].x; a1[j] += s * w[q].y; }
    }
#pragma unroll
    for (int j = 0; j < 9; ++j) { red[(F.wave * 9 + j) * 128 + 2 * F.lane] = a0[j]; red[(F.wave * 9 + j) * 128 + 2 * F.lane + 1] = a1[j]; }
    __syncthreads();
    for (int i = F.tid; i < 9 * 128; i += NWAVES * 64) { const int j = i >> 7, cc = i & 127; float s = 0.f;
#pragma unroll
        for (int w = 0; w < 8; ++w) s += red[(w * 9 + j) * 128 + cc];
        mods[(size_t)(layer * 9 + j) * MODW + col0 + cc] = s + bmod[layer * MODW + col0 + cc]; }
    __syncthreads();
}
__device__ __forceinline__ void p0_prologue(Frame F, ArgsP A) {
    F.refresh();
    unsigned char* ws = A->ws;
    if ((int)blockIdx.x < 144) p0_mod_unit(F, (int)blockIdx.x, A->in[1], A->in[3], A->in[4], A->in[5], (float*)(ws + WS_MODS));
    if ((int)blockIdx.x == F.G - 1) {
        float* rc = (float*)(ws + WS_ROPE); float* rs = rc + 1024;
        for (int i = F.tid; i < 1024; i += NWAVES * 64) { const int pos = i >> 4, fi = i & 15; const float inv = powf(10000.0f, -(float)(2 * fi) / 32.0f); const float ang = (float)pos * inv; rc[i] = cosf(ang); rs[i] = sinf(ang); }
    }
    LAS float* scr = (LAS float*)(F.lds + F.wave * 16384);
    const int gw = F.vcu * NWAVES + F.wave, NGW = F.G * NWAVES;
    constexpr int I13 = (DMODEL / 64) * (N13 / 32), I2 = (DFF / 64) * (DMODEL / 32), IIN = (DMODEL / 64) * (NIN / 32), IOUT = (DMODEL / 64) * (DMODEL / 32);
    constexpr int ILAYER = 2 * I13 + 2 * I2 + IIN + IOUT;
    for (int it = gw; it < 2 * ILAYER; it += NGW) {
        const int l = it / ILAYER; int r = it % ILAYER;
        unsigned char* wl = ws + WS_W + (size_t)l * SZ_WLAYER;
        if (r < I13) { p0_transpose_item<1>(A->in[7] + (size_t)l * DMODEL * N13, DMODEL, N13, (bf16*)(wl + OFF_W13A), scr, r, F.lane); continue; } r -= I13;
        if (r < I13) { p0_transpose_item<1>(A->in[18] + (size_t)l * DMODEL * N13, DMODEL, N13, (bf16*)(wl + OFF_W13B), scr, r, F.lane); continue; } r -= I13;
        if (r < I2) { p0_transpose_item<0>(A->in[8] + (size_t)l * DFF * DMODEL, DFF, DMODEL, (bf16*)(wl + OFF_W2A), scr, r, F.lane); continue; } r -= I2;
        if (r < I2) { p0_transpose_item<0>(A->in[19] + (size_t)l * DFF * DMODEL, DFF, DMODEL, (bf16*)(wl + OFF_W2B), scr, r, F.lane); continue; } r -= I2;
        if (r < IIN) { p0_transpose_item<2>(A->in[10] + (size_t)l * DMODEL * NIN, DMODEL, NIN, (bf16*)(wl + OFF_WIN), scr, r, F.lane); continue; } r -= IIN;
        p0_transpose_item<0>(A->in[16] + (size_t)l * DMODEL * DMODEL, DMODEL, DMODEL, (bf16*)(wl + OFF_WOUT), scr, r, F.lane);
    }
}
__device__ __forceinline__ void modnorm_phase(Frame F, ArgsP A, bool first, bool latent_only, int combine  , const float* g, const float* modl  , int chunk_shift) {
    F.refresh();
    float* xs = (float*)(A->ws + WS_XS); bf16* H = (bf16*)A->out;
    const int gw = F.vcu * NWAVES + F.wave, NGW = F.G * NWAVES;
    for (int row = gw; row < MROWS; row += NGW) {
        const int b = row / RPB, t = row - b * RPB; const bool isctx = t >= SEQL; const int j = isctx ? 8 : b;
        if (isctx && latent_only) continue;
        const float* src = first ? (isctx ? A->in[2] + (size_t)(b * CTXL + t - SEQL) * DMODEL : A->in[0] + (size_t)(b * SEQL + t) * DMODEL) : xs + (size_t)row * DMODEL;
        const GAS f32x4* xr = (const GAS f32x4*)src + F.lane;
        f32x4 v[4]; float s2 = 0.f;
#pragma unroll
        for (int q = 0; q < 4; ++q) { v[q] = xr[64 * q]; s2 += (v[q].x * v[q].x + v[q].y * v[q].y) + (v[q].z * v[q].z + v[q].w * v[q].w); }
        if (combine && row >= 16384) {
#pragma unroll
            for (int ch = 0; ch < 8; ++ch) { const GAS f32x4* pr = (const GAS f32x4*)(pg8::part_slab(A->ws, (unsigned char*)A->out, ch, combine == 2) + (size_t)(row - 16384) * DMODEL) + F.lane;
#pragma unroll
                for (int q = 0; q < 4; ++q) v[q] = v[q] + pr[64 * q]; }
            s2 = 0.f; GAS f32x4* xo = (GAS f32x4*)(xs + (size_t)row * DMODEL) + F.lane;
#pragma unroll
            for (int q = 0; q < 4; ++q) { xo[64 * q] = v[q]; s2 += (v[q].x * v[q].x + v[q].y * v[q].y) + (v[q].z * v[q].z + v[q].w * v[q].w); }
        }
        const float rstd = 1.0f / sqrtf(wave_sum(s2) * (1.0f / DMODEL) + EPS);
        const float* sh = modl + (size_t)j * MODW + chunk_shift * DMODEL; const float* scl = sh + DMODEL;
        if (first) { GAS f32x4* xo = (GAS f32x4*)(xs + (size_t)row * DMODEL) + F.lane;
#pragma unroll
            for (int q = 0; q < 4; ++q) xo[64 * q] = v[q]; }
        GAS unsigned long long* o8 = (GAS unsigned long long*)(H + (size_t)row * DMODEL) + F.lane;
#pragma unroll
        for (int q = 0; q < 4; ++q) { const int col = 4 * F.lane + 256 * q;
            const f32x4 gg = *(const f32x4*)(g + col), sc = *(const f32x4*)(scl + col), sf = *(const f32x4*)(sh + col);
            const f32x4 h = v[q] * rstd * gg * (sc + 1.0f) + sf;
            o8[64 * q] = (unsigned long long)pk2(h.x, h.y) | ((unsigned long long)pk2(h.z, h.w) << 32); }
    }
}
__device__ __forceinline__ void onorm_phase(Frame F, ArgsP A, bool latent_only, const float* ga, const float* gb) {
    F.refresh();
    bf16* O = (bf16*)(A->ws + WS_O);
    const int gw = F.vcu * NWAVES + F.wave, NGW = F.G * NWAVES;
    for (int row = gw; row < MROWS; row += NGW) {
        const int t = row % RPB; if (t >= SEQL && latent_only) continue;
        GAS v4u* p = (GAS v4u*)(O + (size_t)row * DMODEL) + F.lane;
        v4u wa = p[0], wb = p[64]; float xa[8], xb[8]; float sa = 0.f, sb = 0.f;
#pragma unroll
        for (int q = 0; q < 4; ++q) { xa[2 * q] = __builtin_bit_cast(float, wa[q] << 16); xa[2 * q + 1] = __builtin_bit_cast(float, wa[q] & 0xffff0000u);
            xb[2 * q] = __builtin_bit_cast(float, wb[q] << 16); xb[2 * q + 1] = __builtin_bit_cast(float, wb[q] & 0xffff0000u); }
#pragma unroll
        for (int q = 0; q < 8; ++q) { sa += xa[q] * xa[q]; sb += xb[q] * xb[q]; }
        const float ra = 1.0f / sqrtf(wave_sum(sa) * (1.0f / 512.0f) + EPS), rb = 1.0f / sqrtf(wave_sum(sb) * (1.0f / 512.0f) + EPS);
        const f32x4 a0 = *(const f32x4*)(ga + 8 * F.lane), a1 = *(const f32x4*)(ga + 8 * F.lane + 4), b0 = *(const f32x4*)(gb + 8 * F.lane), b1 = *(const f32x4*)(gb + 8 * F.lane + 4);
        v4u oa, ob;
        oa.x = pk2(xa[0] * ra * a0.x, xa[1] * ra * a0.y); oa.y = pk2(xa[2] * ra * a0.z, xa[3] * ra * a0.w); oa.z = pk2(xa[4] * ra * a1.x, xa[5] * ra * a1.y); oa.w = pk2(xa[6] * ra * a1.z, xa[7] * ra * a1.w);
        ob.x = pk2(xb[0] * rb * b0.x, xb[1] * rb * b0.y); ob.y = pk2(xb[2] * rb * b0.z, xb[3] * rb * b0.w); ob.z = pk2(xb[4] * rb * b1.x, xb[5] * rb * b1.y); ob.w = pk2(xb[6] * rb * b1.z, xb[7] * rb * b1.w);
        p[0] = oa; p[64] = ob;
    }
}
__device__ __forceinline__ void final_phase(Frame F, ArgsP A) {
    F.refresh();
    const float* xs = (const float*)(A->ws + WS_XS); const float* g = A->in[20];
    const int gw = F.vcu * NWAVES + F.wave, NGW = F.G * NWAVES;
    for (int r = gw; r < NBATCH * SEQL; r += NGW) {
        const int b = r / SEQL, t = r - b * SEQL;
        const GAS f32x4* xr = (const GAS f32x4*)(xs + (size_t)(b * RPB + t) * DMODEL) + F.lane;
        f32x4 v[4]; float s2 = 0.f;
#pragma unroll
        for (int q = 0; q < 4; ++q) { v[q] = xr[64 * q]; s2 += (v[q].x * v[q].x + v[q].y * v[q].y) + (v[q].z * v[q].z + v[q].w * v[q].w); }
        const float rstd = 1.0f / sqrtf(wave_sum(s2) * (1.0f / DMODEL) + EPS);
        GAS f32x4* o = (GAS f32x4*)(A->out + (size_t)r * DMODEL) + F.lane;
#pragma unroll
        for (int q = 0; q < 4; ++q) o[64 * q] = v[q] * rstd * *(const f32x4*)(g + 4 * F.lane + 256 * q);
    }
}
__device__ __forceinline__ void attn_phase(const Frame& F, ArgsP A, int layer, bool do_ctx, char* lds) {
    const attn_body::bf16* QKV = (const attn_body::bf16*)(A->ws + WS_U); attn_body::bf16* O = (attn_body::bf16*)(A->ws + WS_O);
    const float* rpb = A->in[11] + (size_t)layer * 8 * 15 * 31;
#ifndef NO_MODE0
    {
        const int per = (512 + F.G - 1) / F.G, perc = do_ctx ? (128 + F.G - 1) / F.G : 0;
        for (int i = 0; i < per + perc; ++i) {
            int b, q0, qcol, kcol, vcol, ocol, tb, nt;
            if (i < per) { const int u = per * F.vcu + i; if (u >= 512) continue; const int qb = u & 7, hq = (u >> 3) & 7, kvh = hq >> 2; b = u >> 6; q0 = qb * 256; qcol = 1536 + hq * 64; kcol = 2048 + kvh * 64; vcol = 2176 + kvh * 64; ocol = 512 + hq * 64; tb = 0; nt = 36; }
            else { const int uc = perc * F.vcu + (i - per); if (uc >= 128) continue; const int v = uc & 63, h = v & 7; b = v >> 3; q0 = 2048; tb = 2048; nt = 4;
                if (uc < 64) { qcol = 1536 + h * 64; kcol = 2048 + (h >> 2) * 64; vcol = 2176 + (h >> 2) * 64; ocol = 512 + h * 64; }
                else { qcol = h * 64; kcol = 512 + h * 64; vcol = 1024 + h * 64; ocol = h * 64; } }
            attn_body::attn_unit<0, 8>(b, q0, qcol, kcol, vcol, ocol, tb, nt, 0, nullptr, QKV, O, lds);
        }
    }
#endif
#ifndef NO_MODE1
    for (int i = 0; i < (512 + F.G - 1) / F.G; ++i) {
        const int u = ((512 + F.G - 1) / F.G) * F.vcu + i; if (u >= 512) continue; const int qb = u & 7, h = (u >> 3) & 7, b = u >> 6;
        const int kr0 = min(max(4 * qb - 4, 0), 20);
        attn_body::attn_unit<1, 8>(b, qb * 256, h * 64, 512 + h * 64, 1024 + h * 64, h * 64, 0, 16, kr0, rpb + h * 15 * 31, QKV, O, lds);
    }
#endif
}

__global__ void __launch_bounds__(NWAVES * 64, 2) fwd_megakernel(Args A_unused_directly) {
    extern __shared__ __attribute__((aligned(16))) unsigned char lds[];
    cg::grid_group grid = cg::this_grid();
    Frame F;
    F.lds = (LAS unsigned char*)lds;
    F.refresh();
    F.G = gridDim.x; { const int bx = blockIdx.x; F.vcu = (F.G % 8 == 0) ? (bx % 8) * (F.G / 8) + bx / 8 : bx; }
    for (int u = F.tid; u < (LDS_BYTES - LDSCTL_OFF) / 4; u += NWAVES * 64) ((LAS unsigned*)(F.lds + LDSCTL_OFF))[u] = 0u;
    __syncthreads();
    XcdBarrier bar = xcd_barrier_post((unsigned*)(get_args()->ws + WS_CTL) + CW_BAR, (volatile LAS unsigned*)(F.lds + MISC_OFF) + 8);
#ifdef ALL_CG_SYNC
#define GRID_BAR() grid.sync()
#else
#define GRID_BAR() xcd_barrier(bar)
#endif

    p0_prologue(F, get_args());
#ifdef PROBE_P0X2
    __syncthreads(); p0_prologue(F, A);
#endif
    grid.sync();
    for (int l = 0; l < 2; ++l) {
        const bool last = (l == 1);
#define MODL(A_) ((const float*)((A_)->ws + WS_MODS) + (size_t)l * 9 * MODW)
#define WL(A_) ((A_)->ws + WS_W + (size_t)l * SZ_WLAYER)
        for (int f = 0; f < 2; ++f) {
            const bool lat = last && f == 1;
            { ArgsP A = get_args(); modnorm_phase(F, A, l == 0 && f == 0, lat, (l == 1 && f == 0) ? 1 : ((l == 0 && f == 1) ? 2 : 0)  , (f == 0 ? A->in[6] : A->in[17]) + l * DMODEL, MODL(A), f == 0 ? 0 : 6); }
#ifdef PROBE_NORMX2
            if (f == 1) { GRID_BAR(); ArgsP A = get_args(); modnorm_phase(F, A, false, lat, false, A->in[17] + l * DMODEL, MODL(A), 6); }
#endif
            GRID_BAR();
            {
                ArgsP A = get_args(); unsigned char* ws = A->ws; unsigned char* wl = WL(A);
                pg8::Gemm g{(const pg8::bf16_t*)A->out, (const pg8::bf16_t*)(wl + (f == 0 ? OFF_W13A : OFF_W13B)), MROWS, N13, DMODEL};
                pg8::Sched2 S; S.init(N13, DMODEL, F.G, (int)blockIdx.x, lat, false);
                pg8::EpiSwiglu E{(pg8::bf16_t*)(ws + WS_U), DFF};
#ifndef NO_G1
                pg8::gemm_phase<pg8::EpiSwiglu, pg8::Sched2, true, true>(F.lds, g, S, E);
#endif
#ifdef PROBE_G1X2
                GRID_BAR(); pg8::gemm_phase<pg8::EpiSwiglu, pg8::Sched2, true, true>(F.lds, g, S, E);
#endif
            }
            GRID_BAR();
            {
                ArgsP A = get_args(); unsigned char* ws = A->ws; unsigned char* wl = WL(A); const float* modl = MODL(A);
                pg8::Gemm g{(const pg8::bf16_t*)(ws + WS_U), (const pg8::bf16_t*)(wl + (f == 0 ? OFF_W2A : OFF_W2B)), MROWS, DMODEL, DFF};
                pg8::Sched2 S; S.init(DMODEL, DFF, F.G, (int)blockIdx.x, lat, true);
                pg8::EpiResid E{(float*)(ws + WS_XS), modl + (f == 0 ? 2 : 8) * DMODEL, 0.5f, ws, (unsigned char*)A->out, 0};
#ifndef NO_G2
                pg8::gemm_phase<pg8::EpiResid, pg8::Sched2, true, true>(F.lds, g, S, E);
#endif
#ifdef PROBE_G2X3
                if (!(l == 1 && f == 1)) { GRID_BAR(); E.s = -0.5f; S.cpu = 0; S.full = S.nwg; pg8::gemm_phase<pg8::EpiResid, pg8::Sched2, true, true>(F.lds, g, S, E);
                GRID_BAR(); E.s = 0.5f; pg8::gemm_phase<pg8::EpiResid, pg8::Sched2, true, true>(F.lds, g, S, E); }
#endif
            }
            GRID_BAR();
            if (f == 0) {
                { ArgsP A = get_args(); modnorm_phase(F, A, false, false, 1  , A->in[9] + l * DMODEL, MODL(A), 3); }
                GRID_BAR();
                {
                    ArgsP A = get_args(); unsigned char* ws = A->ws; unsigned char* wl = WL(A); const float* rc = (const float*)(ws + WS_ROPE); const float* rs = rc + 1024;
                    pg8::Gemm g{(const pg8::bf16_t*)A->out, (const pg8::bf16_t*)(wl + OFF_WIN), MROWS, NIN, DMODEL};
                    pg8::Sched2 S; S.init(NIN, DMODEL, F.G, (int)blockIdx.x, false, false);
                    LAS float* ropel = (LAS float*)(F.lds + ROPE_LDS_OFF);
                    for (int i = threadIdx.x; i < 2048; i += NWAVES * 64) ropel[i] = rc[i];
                    __syncthreads();
                    pg8::EpiQkv E{(pg8::bf16_t*)(ws + WS_U), A->in[12] + l * 64, A->in[13] + l * 64, ropel, ropel + 1024, QC2, EPS};
#ifndef NO_GIN
                    pg8::gemm_phase<pg8::EpiQkv, pg8::Sched2, true, true>(F.lds, g, S, E);
#endif
#ifdef PROBE_GINX2
                    GRID_BAR(); pg8::gemm_phase<pg8::EpiQkv, pg8::Sched2, true, true>(F.lds, g, S, E);
#endif
                }
                GRID_BAR();
#ifndef NO_ATTN
                attn_phase(F, get_args(), l, !last, (char*)lds);
#endif
#ifdef PROBE_ATTNX2
                GRID_BAR(); attn_phase(F, get_args(), l, !last, (char*)lds);
#endif
                GRID_BAR();
                { ArgsP A = get_args(); onorm_phase(F, A, last, A->in[14] + l * 512, A->in[15] + l * 512); }
                GRID_BAR();
                {
                    ArgsP A = get_args(); unsigned char* ws = A->ws; unsigned char* wl = WL(A); const float* modl = MODL(A);
                    pg8::Gemm g{(const pg8::bf16_t*)(ws + WS_O), (const pg8::bf16_t*)(wl + OFF_WOUT), MROWS, DMODEL, DMODEL};
                    pg8::Sched2 S; S.init(DMODEL, DMODEL, F.G, (int)blockIdx.x, last, true);
                    pg8::EpiResid E{(float*)(ws + WS_XS), modl + 5 * DMODEL, 1.0f, ws, (unsigned char*)A->out, 1};
#ifndef NO_GOUT
                    pg8::gemm_phase<pg8::EpiResid, pg8::Sched2, true, true>(F.lds, g, S, E);
#endif
                }
                GRID_BAR();
            }
        }
    }
    final_phase(F, get_args());
}

extern "C" void kernel_launch(void* const* d_in, const int* in_sizes, int n_in, void* d_out, int out_size, void* d_ws, size_t ws_size, hipStream_t stream) {
    static int grid = 0;
    if (grid == 0) {
        if (n_in != 21 || out_size != NBATCH * SEQL * DMODEL || ws_size < WS_END + pg8::SLAB_BYTES) { fprintf(stderr, "kernel_launch: unexpected shapes (n_in %d, out %d, ws %zu, need %zu)\n", n_in, out_size, ws_size, (size_t)WS_END); grid = -1; return; }
        int dev = 0, cus = 0, per_cu = 0;
        if (hipGetDevice(&dev) != hipSuccess || hipDeviceGetAttribute(&cus, hipDeviceAttributeMultiprocessorCount, dev) != hipSuccess) { grid = -1; return; }
        if (hipFuncSetAttribute((const void*)fwd_megakernel, hipFuncAttributeMaxDynamicSharedMemorySize, LDS_BYTES) != hipSuccess) { fprintf(stderr, "kernel_launch: hipFuncSetAttribute failed\n"); grid = -1; return; }
        if (hipOccupancyMaxActiveBlocksPerMultiprocessor(&per_cu, (const void*)fwd_megakernel, NWAVES * 64, LDS_BYTES) != hipSuccess || per_cu < 1) { fprintf(stderr, "kernel_launch: occupancy query says %d blocks per CU\n", per_cu); (void)hipGetLastError(); grid = -1; return; }
        grid = cus;
    }
    if (grid < 0) return;
    (void)hipMemsetAsync((char*)d_ws + WS_CTL, 0, CTL_ZERO_BYTES, stream);
    Args a{};
    for (int i = 0; i < 21; ++i) a.in[i] = (const float*)d_in[i];
    a.out = (float*)d_out; a.ws = (unsigned char*)d_ws;
    void* args[] = {&a};
    hipError_t e = hipLaunchCooperativeKernel((const void*)fwd_megakernel, dim3(grid), dim3(NWAVES * 64), args, LDS_BYTES, stream);
    if (e != hipSuccess) fprintf(stderr, "kernel_launch: cooperative launch failed: %s (grid %d)\n", hipGetErrorString(e), grid);
}
```
